# Optimizing an MI355X kernel written in HIP

```python
import jax, jax.numpy as jnp
from jax import lax
import numpy as np

D_MODEL = 2048
BATCH = 4
SEQ = 4096
DEPTH = 1

N_META = 16
CHUNK = 128
RET_HEADS = 4
RET_QK = 128
RET_V = 256
RET_ROT_BASE = 10000.0
DIFF_HEADS = 4
DIFF_QK = 128
DIFF_V = 256
ROT_DIMS = DIFF_QK // 4
ROPE_THETA = 500000.0
N_GROUPS = 8
EXPERTS_PER_GROUP = 8
N_EXPERTS = N_GROUPS * EXPERTS_PER_GROUP
TOP_K = 2
EXPERT_FF = 512
EPS = 1e-6
NEG_INF = -1e30

RET_WIDTH = RET_HEADS * RET_V
DIFF_WIDTH = DIFF_HEADS * DIFF_V
MIX_WIDTH = RET_WIDTH + DIFF_WIDTH
IN_SPLITS = [RET_HEADS * RET_QK, RET_HEADS * RET_QK, RET_WIDTH, RET_WIDTH,
             DIFF_HEADS * 2 * DIFF_QK, DIFF_HEADS * 2 * DIFF_QK, DIFF_WIDTH]
IN_WIDTH = int(sum(IN_SPLITS))
IN_OFFSETS = [int(o) for o in np.cumsum(IN_SPLITS)[:-1]]

kernel_name = "hymba_retnet_diffattn_hiermoe"


def _rms(x):
    xf = x.astype(jnp.float32)
    return (xf * lax.rsqrt(jnp.mean(xf * xf, -1, keepdims=True) + EPS)).astype(x.dtype)


def rmsnorm(x, g):
    xf = x.astype(jnp.float32)
    y = xf * lax.rsqrt(jnp.mean(xf * xf, -1, keepdims=True) + EPS)
    return (y * g.astype(jnp.float32)).astype(x.dtype)


def rope_tables(pos, inv_freq, dtype):
    ang = pos[:, None] * inv_freq[None, :]
    return jnp.cos(ang).astype(dtype), jnp.sin(ang).astype(dtype)


def apply_rope(x, cos, sin):
    x1, x2 = jnp.split(x, 2, axis=-1)
    return jnp.concatenate([x1 * cos - x2 * sin, x1 * sin + x2 * cos], axis=-1)


def apply_partial_rope(x, cos, sin):
    return jnp.concatenate([apply_rope(x[..., :ROT_DIMS], cos, sin), x[..., ROT_DIMS:]], axis=-1)


def to_chunks(t, n_chunks):
    b, h, _, d = t.shape
    return t.reshape(b, h, n_chunks, CHUNK, d).transpose(2, 0, 1, 3, 4)


def from_chunks(t):
    n, b, h, c, d = t.shape
    return t.transpose(1, 0, 3, 2, 4).reshape(b, n * c, h * d)


def retention(q, k, v, gate, pos, valid):
    dt = q.dtype
    n_chunks = q.shape[2] // CHUNK
    inv = 1.0 / (RET_ROT_BASE ** jnp.linspace(0.0, 1.0, RET_QK // 2, dtype=jnp.float32))
    cos, sin = rope_tables(pos, inv, dt)
    vm = valid.astype(dt)[None, None, :, None]
    q = apply_rope(q, cos, sin)
    k = apply_rope(k, cos, sin) * (RET_QK ** -0.5) * vm
    v = v * vm
    log_g = jnp.log(1.0 - 2.0 ** (-5.0 - jnp.arange(RET_HEADS, dtype=jnp.float32)))
    idx = jnp.arange(CHUNK, dtype=jnp.float32)
    dist = idx[:, None] - idx[None, :]
    decay_mask = jnp.where(dist >= 0, jnp.exp(jnp.maximum(dist, 0.0)[None] * log_g[:, None, None]), 0.0).astype(dt)
    xi = jnp.exp((idx + 1.0)[None, :] * log_g[:, None]).astype(dt)
    zeta = jnp.exp((CHUNK - 1.0 - idx)[None, :] * log_g[:, None]).astype(dt)
    chunk_decay = jnp.exp(CHUNK * log_g).astype(dt)
    qc, kc, vc = to_chunks(q, n_chunks), to_chunks(k, n_chunks), to_chunks(v, n_chunks)
    scores = jnp.einsum('nbhcd,nbhsd->nbhcs', qc, kc) * decay_mask[None, None]
    inner = jnp.einsum('nbhcs,nbhse->nbhce', scores, vc)
    kv = jnp.einsum('nbhcd,nbhce->nbhde', kc * zeta[None, None, :, :, None], vc)

    def step(state, inp):
        q_i, kv_i = inp
        o = jnp.einsum('bhcd,bhde->bhce', q_i, state)
        return state * chunk_decay[None, :, None, None] + kv_i, o

    b = q.shape[0]
    state0 = jnp.zeros((b, RET_HEADS, RET_QK, RET_V), dt)
    _, cross = lax.scan(step, state0, (qc, kv))
    out = inner + cross * xi[None, None, :, :, None]
    out = from_chunks(_rms(out))
    return jax.nn.silu(gate) * out


def diff_attention(q, k, v, pos, valid, lq1, lk1, lq2, lk2, subln_g, lambda_init):
    dt = q.dtype
    L = q.shape[3]
    n_blocks = L // CHUNK
    inv = ROPE_THETA ** (-jnp.arange(0, ROT_DIMS, 2, dtype=jnp.float32) / ROT_DIMS)
    cos, sin = rope_tables(pos, inv, dt)
    q = apply_partial_rope(q, cos, sin) * (DIFF_QK ** -0.5)
    k = apply_partial_rope(k, cos, sin)
    lam = (jnp.exp(jnp.sum(lq1.astype(jnp.float32) * lk1.astype(jnp.float32)))
           - jnp.exp(jnp.sum(lq2.astype(jnp.float32) * lk2.astype(jnp.float32))) + lambda_init)
    b = q.shape[0]
    qb = q.reshape(b, 2, DIFF_HEADS, n_blocks, CHUNK, DIFF_QK).transpose(3, 0, 1, 2, 4, 5)
    kpos = jnp.arange(L)

    def block(args):
        q_blk, i = args
        s = jnp.einsum('bjhcd,bjhsd->bjhcs', q_blk, k).astype(jnp.float32)
        qpos = i * CHUNK + jnp.arange(CHUNK)
        allowed = (kpos[None, :] <= qpos[:, None]) & valid[None, :]
        p = jax.nn.softmax(jnp.where(allowed, s, NEG_INF), axis=-1)
        a = (p[:, 0] - lam * p[:, 1]).astype(v.dtype)
        return jnp.einsum('bhcs,bhse->bhce', a, v)

    out = lax.map(block, (qb, jnp.arange(n_blocks)))
    out = rmsnorm(out, subln_g) * (1.0 - lambda_init)
    return from_chunks(out)


def hier_moe(u, w_group_router, w_expert_router, w_gate, w_up, w_down):
    t = u.shape[0]
    g_logits = jnp.einsum('td,dg->tg', u, w_group_router).astype(jnp.float32)
    g_prob = jax.nn.softmax(g_logits, axis=-1)
    g_star = jnp.argmax(g_prob, axis=-1)
    g_gate = jnp.take_along_axis(g_prob, g_star[:, None], axis=-1)[:, 0]
    e_logits = jnp.einsum('td,de->te', u, w_expert_router).astype(jnp.float32)
    e_logits = e_logits.reshape(t, N_GROUPS, EXPERTS_PER_GROUP)
    e_sel = jnp.take_along_axis(e_logits, g_star[:, None, None], axis=1)[:, 0]
    e_prob = jax.nn.softmax(e_sel, axis=-1)
    top_p, top_i = lax.top_k(e_prob, TOP_K)
    top_p = top_p / jnp.sum(top_p, axis=-1, keepdims=True)
    weights = (g_gate[:, None] * top_p).astype(u.dtype)
    expert_id = (g_star[:, None] * EXPERTS_PER_GROUP + top_i).reshape(-1)
    order = jnp.argsort(expert_id)
    tok = order // TOP_K
    xs = u[tok]
    sizes = jnp.bincount(expert_id, length=N_EXPERTS).astype(jnp.int32)
    hg = lax.ragged_dot(xs, w_gate, sizes)
    hu = lax.ragged_dot(xs, w_up, sizes)
    y = lax.ragged_dot(jax.nn.silu(hg) * hu, w_down, sizes)
    y = y * weights.reshape(-1)[order][:, None]
    return jnp.zeros_like(u).at[tok].add(y)


def setup_inputs(seed: int = 0) -> dict:
    key = jax.random.key(seed)
    ks = jax.random.split(key, 17)
    f32 = jnp.float32
    nrm = lambda k, shape, scale: (jax.random.normal(k, shape, f32) * scale).astype(f32)
    gain = lambda k, shape: (1.0 + 0.01 * jax.random.normal(k, shape, f32)).astype(f32)
    return {
        "x": nrm(ks[0], (BATCH, SEQ, D_MODEL), 1.0),
        "meta_tokens": nrm(ks[1], (N_META, D_MODEL), 1.0),
        "attn_norm_g": gain(ks[2], (DEPTH, D_MODEL)),
        "w_in": nrm(ks[3], (DEPTH, D_MODEL, IN_WIDTH), D_MODEL ** -0.5),
        "w_out": nrm(ks[4], (DEPTH, MIX_WIDTH, D_MODEL), MIX_WIDTH ** -0.5),
        "lambda_q1": nrm(ks[5], (DEPTH, DIFF_QK), 0.1),
        "lambda_k1": nrm(ks[6], (DEPTH, DIFF_QK), 0.1),
        "lambda_q2": nrm(ks[7], (DEPTH, DIFF_QK), 0.1),
        "lambda_k2": nrm(ks[8], (DEPTH, DIFF_QK), 0.1),
        "diff_subln_g": gain(ks[9], (DEPTH, DIFF_V)),
        "ffn_norm_g": gain(ks[10], (DEPTH, D_MODEL)),
        "w_group_router": nrm(ks[11], (DEPTH, D_MODEL, N_GROUPS), D_MODEL ** -0.5),
        "w_expert_router": nrm(ks[12], (DEPTH, D_MODEL, N_EXPERTS), D_MODEL ** -0.5),
        "w_gate": nrm(ks[13], (DEPTH, N_EXPERTS, D_MODEL, EXPERT_FF), D_MODEL ** -0.5),
        "w_up": nrm(ks[14], (DEPTH, N_EXPERTS, D_MODEL, EXPERT_FF), D_MODEL ** -0.5),
        "w_down": nrm(ks[15], (DEPTH, N_EXPERTS, EXPERT_FF, D_MODEL), EXPERT_FF ** -0.5),
        "final_norm_g": gain(ks[16], (D_MODEL,)),
    }


def reference(x, meta_tokens, attn_norm_g, w_in, w_out, lambda_q1, lambda_k1, lambda_q2, lambda_k2,
              diff_subln_g, ffn_norm_g, w_group_router, w_expert_router, w_gate, w_up, w_down,
              final_norm_g):
    b, s, d = x.shape
    dt = x.dtype
    n_pad = CHUNK - N_META
    L = CHUNK + s
    h = jnp.concatenate([jnp.zeros((b, n_pad, d), dt),
                         jnp.broadcast_to(meta_tokens.astype(dt)[None], (b, N_META, d)), x], axis=1)
    pos_i = jnp.arange(L) - n_pad
    valid = pos_i >= 0
    pos = pos_i.astype(jnp.float32)
    row_mask = valid.astype(dt)[None, :, None]

    for l in range(DEPTH):
        lambda_init = 0.8 - 0.6 * float(np.exp(-0.3 * l))
        u = rmsnorm(h, attn_norm_g[l])
        proj = jnp.einsum('bld,de->ble', u, w_in[l])
        rq, rk, rv, rg, dq, dk, dv = jnp.split(proj, IN_OFFSETS, axis=-1)
        heads = lambda t, nh: t.reshape(b, L, nh, -1).transpose(0, 2, 1, 3)
        pair = lambda t: t.reshape(b, L, DIFF_HEADS, 2, DIFF_QK).transpose(0, 3, 2, 1, 4)
        y_ret = retention(heads(rq, RET_HEADS), heads(rk, RET_HEADS), heads(rv, RET_HEADS), rg, pos, valid)
        y_diff = diff_attention(pair(dq), pair(dk), heads(dv, DIFF_HEADS), pos, valid,
                                lambda_q1[l], lambda_k1[l], lambda_q2[l], lambda_k2[l],
                                diff_subln_g[l], lambda_init)
        mixed = jnp.concatenate([y_ret, y_diff], axis=-1)
        h = h + row_mask * jnp.einsum('ble,ed->bld', mixed, w_out[l])
        u = rmsnorm(h, ffn_norm_g[l]).reshape(b * L, d)
        f = hier_moe(u, w_group_router[l], w_expert_router[l], w_gate[l], w_up[l], w_down[l])
        h = h + row_mask * f.reshape(b, L, d)

    return rmsnorm(h, final_norm_g)[:, CHUNK:, :]
```

```cpp
#define MK_N_LAUNCHES 10
#include <hip/hip_runtime.h>
#include <cstdio>
#include <cstdint>
#include <cmath>
namespace pg8 {
#define PG8_LAS __attribute__((address_space(3)))
typedef unsigned short bf16_t;
typedef short bf16x8 __attribute__((ext_vector_type(8)));
typedef float f32x4 __attribute__((ext_vector_type(4)));
typedef unsigned u32x4 __attribute__((ext_vector_type(4)));
constexpr int BM = 256, BK = 64, HALF = 128, HTB = HALF * BK * 2  , STAGE_BYTES = 8 * HTB, NXCD = 8, WGM = 8;

__host__ __device__ __forceinline__ int lds_byte(int r, int c) { const int st = (r >> 4) * 2 + (c >> 5), rr = r & 15, cc = c & 31, ob = rr * 64 + cc * 2; return st * 1024 + (ob ^ (((ob >> 9) & 1) << 5)); }
__host__ __device__ __forceinline__ void stage_rc(int b, int& R, int& C) { const int st = b / 1024, sb = b % 1024, swz = sb ^ (((sb >> 9) & 1) << 5); R = (st >> 1) * 16 + swz / 64; C = (st & 1) * 32 + (swz % 64) / 2; }
__host__ __device__ __forceinline__ int perm32(int rho) { const int n = rho >> 4, i = rho & 15; return 8 * (i >> 2) + 4 * n + (i & 3); }

struct Unit { int pm, pn, aux; };
struct Gemm { const bf16_t* A; const bf16_t* Bt; int M, N, K; };

struct StaticOrder {
    int nM, nN, nwg, G, c;
    __host__ __device__ void init(int M, int N, int G_, int c_) { nM = M / BM; nN = N / BM; nwg = nM * nN; G = G_; c = c_; }
    __host__ __device__ bool next(int i, Unit& u) const {
        const long L = (long)i * G + c; if (L >= nwg) return false;
        int wgid = (int)L; { const int q = nwg / NXCD, r = nwg % NXCD, xcd = wgid % NXCD, off = wgid / NXCD; wgid = (xcd < r ? xcd * (q + 1) : r * (q + 1) + (xcd - r) * q) + off; }
        const int nig = WGM * nN, gid = wgid / nig, fm = gid * WGM, gsz = (nM - fm) < WGM ? (nM - fm) : WGM;
        u.pm = fm + ((wgid % nig) % gsz); u.pn = (wgid % nig) / gsz; return true;
    }
    __device__ __forceinline__ unsigned rowoff(const Unit&, int) const { return 0u; }
};

__device__ __forceinline__ unsigned cvt_pk_bf16(float lo, float hi) { unsigned r; asm volatile("v_cvt_pk_bf16_f32 %0, %1, %2" : "=v"(r) : "v"(lo), "v"(hi)); return r; }

template <class Epi, class Sched, bool GATHER>
__device__ __forceinline__ void gemm_phase(PG8_LAS unsigned char* lds, const Gemm g, const Sched& S, const Epi& E) {
    const int tid = threadIdx.x, wid = __builtin_amdgcn_readfirstlane(tid >> 6), lane = tid & 63, wr = wid >> 2, wc = wid & 3, fr = lane & 15, fq = lane >> 4;
    const int K = g.K, nt = K / BK;
    unsigned voffA[2], voffB[2]; int RA[2], CA[2];
#pragma unroll
    for (int i = 0; i < 2; ++i) { int R, C; stage_rc(tid * 16 + i * 8192, R, C); const int Rb = Epi::PERM ? ((R & ~31) + perm32(R & 31)) : R;
        RA[i] = R; CA[i] = C; voffA[i] = (unsigned)(R * K + C) * 2u; voffB[i] = (unsigned)(Rb * K + C) * 2u; }
    const size_t kstep = (size_t)(BK * 2);
    const size_t hstep = (size_t)HALF * K * 2;
    const size_t tstep = 2 * hstep;
    const unsigned ldsw = (unsigned)wid * 1024u;
    const int aoff = lds_byte(wr * 64 + fr, fq * 8), boff = lds_byte(wc * 32 + fr, fq * 8);
#define PG8_SA(b, h) (((b) * 2 + (h)) * HTB)
#define PG8_SB(b, h) ((4 + (b) * 2 + (h)) * HTB)
#define PG8_STAGE(bufoff, gbase, voff) do { _Pragma("unroll") for (int _i = 0; _i < 2; ++_i) \
        __builtin_amdgcn_global_load_lds((const unsigned*)((const char*)(gbase) + (voff)[_i]), (PG8_LAS unsigned*)(lds + (bufoff) + ldsw + _i * 8192), 16, 0, 0); } while (0)
#define PG8_STAGE_A(bufoff, gb, h, nx) do { if constexpr (GATHER) { _Pragma("unroll") for (int _i = 0; _i < 2; ++_i) \
        __builtin_amdgcn_global_load_lds((const unsigned*)((const char*)(gb) + ((nx) ? vGn[h][_i] : vGc[h][_i])), (PG8_LAS unsigned*)(lds + (bufoff) + ldsw + _i * 8192), 16, 0, 0); } \
        else { PG8_STAGE(bufoff, (gb) + (h) * hstep, voffA); } } while (0)
#define PG8_LDA(dst, b, h) do { _Pragma("unroll") for (int m = 0; m < 4; ++m) _Pragma("unroll") for (int k = 0; k < 2; ++k) dst[m][k] = *(const PG8_LAS bf16x8*)(lds + PG8_SA(b, h) + aoff + m * 2048 + k * 1024); } while (0)
#define PG8_LDB(dst, b, h) do { _Pragma("unroll") for (int n = 0; n < 2; ++n) _Pragma("unroll") for (int k = 0; k < 2; ++k) dst[n][k] = *(const PG8_LAS bf16x8*)(lds + PG8_SB(b, h) + boff + n * 2048 + k * 1024); } while (0)
#define PG8_MMA(ai, bj, At, Bt) do { __builtin_amdgcn_s_setprio(1); _Pragma("unroll") for (int m = 0; m < 4; ++m) _Pragma("unroll") for (int n = 0; n < 2; ++n) _Pragma("unroll") for (int k = 0; k < 2; ++k) \
        acc[ai][bj][m][n] = __builtin_amdgcn_mfma_f32_16x16x32_bf16(Bt[n][k], At[m][k], acc[ai][bj][m][n], 0, 0, 0); __builtin_amdgcn_s_setprio(0); } while (0)
#define PG8_WAIT_V(n) asm volatile("s_waitcnt vmcnt(" #n ")" ::: "memory")
#define PG8_WAIT_L(n) asm volatile("s_waitcnt lgkmcnt(" #n ")" ::: "memory")
#define PG8_BAR __builtin_amdgcn_s_barrier()
#define PG8_SCHED __builtin_amdgcn_sched_barrier(0)
    Unit cur, nxt; int ui = 0;
    if (!S.next(0, cur)) return;
    f32x4 acc[2][2][4][2];
#pragma unroll
    for (int a = 0; a < 2; ++a)
#pragma unroll
        for (int b = 0; b < 2; ++b)
#pragma unroll
            for (int m = 0; m < 4; ++m)
#pragma unroll
                for (int n = 0; n < 2; ++n) acc[a][b][m][n] = (f32x4){0.f, 0.f, 0.f, 0.f};
    bf16x8 At[4][2], B0[2][2], B1[2][2];
    unsigned vGc[2][2] = {{0u, 0u}, {0u, 0u}}, vGn[2][2] = {{0u, 0u}, {0u, 0u}};
    if constexpr (GATHER) {
#pragma unroll
        for (int h = 0; h < 2; ++h)
#pragma unroll
            for (int i = 0; i < 2; ++i) { vGc[h][i] = S.rowoff(cur, h * HALF + RA[i]) + (unsigned)CA[i] * 2u; vGn[h][i] = vGc[h][i]; }
    }
    const char* cA = GATHER ? (const char*)g.A : (const char*)g.A + (size_t)cur.pm * tstep; const char* cB = (const char*)g.Bt + (size_t)cur.pn * tstep;
    PG8_STAGE(PG8_SB(0, 0), cB, voffB); PG8_STAGE(PG8_SB(0, 1), cB + hstep, voffB); PG8_STAGE_A(PG8_SA(0, 0), cA, 0, false); PG8_STAGE_A(PG8_SA(0, 1), cA, 1, false);
    if (wr == 1) PG8_BAR;
    PG8_WAIT_V(2); PG8_BAR;
    PG8_STAGE(PG8_SB(1, 0), cB + kstep, voffB); PG8_STAGE_A(PG8_SA(1, 0), cA + kstep, 0, false); PG8_STAGE(PG8_SB(1, 1), cB + hstep + kstep, voffB);
    PG8_WAIT_V(6); PG8_BAR;
    for (;;) {
        const bool has_next = S.next(ui + 1, nxt);
        if constexpr (GATHER) { if (has_next) {
#pragma unroll
            for (int h = 0; h < 2; ++h)
#pragma unroll
                for (int i = 0; i < 2; ++i) vGn[h][i] = S.rowoff(nxt, h * HALF + RA[i]) + (unsigned)CA[i] * 2u; } }
        const char* nA = GATHER ? cA : (has_next ? (const char*)g.A + (size_t)nxt.pm * tstep : cA); const char* nB = has_next ? (const char*)g.Bt + (size_t)nxt.pn * tstep : cB;
        for (int t = 0; t < nt; t += 2) {
            const bool last = (t == nt - 2);
            const char* a1 = cA + (size_t)(t + 1) * kstep;
            const char* a2 = last ? nA : cA + (size_t)(t + 2) * kstep; const char* b2 = last ? nB : cB + (size_t)(t + 2) * kstep;
            const char* a3 = a2 + kstep; const char* b3 = b2 + kstep;
            PG8_LDB(B0, 0, 0); PG8_LDB(B1, 0, 1); PG8_SCHED; PG8_LDA(At, 0, 0); PG8_STAGE_A(PG8_SA(1, 1), a1, 1, false);
            PG8_WAIT_V(8); PG8_WAIT_L(0); PG8_BAR; PG8_MMA(0, 0, At, B0); PG8_MMA(0, 1, At, B1); PG8_BAR; PG8_SCHED;
            PG8_LDA(At, 0, 1); PG8_STAGE(PG8_SB(0, 0), b2, voffB); PG8_STAGE(PG8_SB(0, 1), b2 + hstep, voffB); PG8_STAGE_A(PG8_SA(0, 0), a2, 0, last);
            PG8_WAIT_V(8); PG8_WAIT_L(0); PG8_BAR; PG8_MMA(1, 0, At, B0); PG8_MMA(1, 1, At, B1); PG8_BAR; PG8_SCHED;
            PG8_LDB(B0, 1, 0); PG8_LDB(B1, 1, 1); PG8_SCHED; PG8_LDA(At, 1, 0); PG8_STAGE_A(PG8_SA(0, 1), a2, 1, last);
            PG8_WAIT_V(8); PG8_WAIT_L(0); PG8_BAR; PG8_MMA(0, 0, At, B0); PG8_MMA(0, 1, At, B1); PG8_BAR; PG8_SCHED;
            PG8_LDA(At, 1, 1); PG8_STAGE(PG8_SB(1, 0), b3, voffB); PG8_STAGE(PG8_SB(1, 1), b3 + hstep, voffB); PG8_STAGE_A(PG8_SA(1, 0), a3, 0, last);
            PG8_WAIT_V(8); PG8_WAIT_L(0); PG8_BAR; PG8_MMA(1, 0, At, B0); PG8_MMA(1, 1, At, B1); PG8_BAR; PG8_SCHED;
        }
        if (wr == 0) PG8_BAR;
        E(acc, cur, wr, wc, fr, fq);
        if (!has_next) break;
#pragma unroll
        for (int a = 0; a < 2; ++a)
#pragma unroll
            for (int b = 0; b < 2; ++b)
#pragma unroll
                for (int m = 0; m < 4; ++m)
#pragma unroll
                    for (int n = 0; n < 2; ++n) acc[a][b][m][n] = (f32x4){0.f, 0.f, 0.f, 0.f};
        cur = nxt; cA = nA; cB = nB; ++ui;
        if constexpr (GATHER) {
#pragma unroll
            for (int h = 0; h < 2; ++h)
#pragma unroll
                for (int i = 0; i < 2; ++i) vGc[h][i] = vGn[h][i]; }
        if (wr == 1) PG8_BAR;
    }
    PG8_WAIT_V(0);
    PG8_BAR;
#undef PG8_SA
#undef PG8_SB
#undef PG8_STAGE
#undef PG8_STAGE_A
#undef PG8_LDA
#undef PG8_LDB
#undef PG8_MMA
#undef PG8_WAIT_V
#undef PG8_WAIT_L
#undef PG8_BAR
#undef PG8_SCHED
}
}
#define GAS __attribute__((address_space(1)))
#define LAS __attribute__((address_space(3)))
typedef unsigned short bf16;
typedef unsigned v4u __attribute__((ext_vector_type(4)));
typedef float f32x4 __attribute__((ext_vector_type(4)));
typedef short bf16x8 __attribute__((ext_vector_type(8)));
typedef GAS unsigned gu32;
typedef GAS unsigned long long gu64;
#define RLX_AGENT __ATOMIC_RELAXED, __HIP_MEMORY_SCOPE_AGENT
#define LDS_WAIT() asm volatile("s_waitcnt lgkmcnt(0)" ::: "memory")
#define VM_WAIT() asm volatile("s_waitcnt vmcnt(0)" ::: "memory")
__device__ __forceinline__ unsigned long long rt() { return __builtin_amdgcn_s_memrealtime(); }
__device__ __forceinline__ unsigned f2bf(float f) { unsigned u = __builtin_bit_cast(unsigned, f); return (u + 0x7fffu + ((u >> 16) & 1u)) >> 16; }
__device__ __forceinline__ unsigned pk2(float lo, float hi) { return f2bf(lo) | (f2bf(hi) << 16); }
#define XB_TMO      128
#define XB_XCNT(j)  (256  + 64 * (j))
#define XB_XSUB(j)  (1280 + 64 * (j))
#define XB_XGEN(j)  (2304 + 64 * (j))
#define XB_TOP      3328
#define XB_TOPGEN   3392
#define XCD_BAR_WORDS 3456
#define XB_SPIN_CAP (1u << 18)

__device__ __forceinline__ unsigned xb_ld(unsigned* p)              { return __hip_atomic_load(p, __ATOMIC_RELAXED, __HIP_MEMORY_SCOPE_AGENT); }
__device__ __forceinline__ unsigned xb_add(unsigned* p, unsigned v) { return __hip_atomic_fetch_add(p, v, __ATOMIC_RELAXED, __HIP_MEMORY_SCOPE_AGENT); }
__device__ __forceinline__ unsigned xb_xcc_id() { return (unsigned)__builtin_amdgcn_s_getreg((3 << 11) | 20) & 0xFu; }
#define XB_SPIN(cond, bar) do { unsigned _sp = 0; while (cond) { __builtin_amdgcn_s_sleep(1); \
    if ((++_sp & 255u) == 0u) { if (xb_ld(&(bar)[XB_TMO])) break; if (_sp > XB_SPIN_CAP) { atomicAdd(&(bar)[XB_TMO], 1u); break; } } } } while (0)

struct XcdBarrier {
    unsigned* bar; unsigned x;
    volatile LAS unsigned* st;
};

__device__ __forceinline__ XcdBarrier xcd_barrier_post(unsigned* bar, volatile LAS unsigned* st) {
    XcdBarrier b; b.bar = bar; b.x = xb_xcc_id(); b.st = st;
    if (threadIdx.x == 0) (void)xb_add(&bar[XB_XCNT(b.x)], 1u);
    return b;
}
__device__ __forceinline__ void xcd_barrier_complete(unsigned* bar, unsigned x, unsigned& nloc, unsigned& nx) {
    const unsigned G = gridDim.x * gridDim.y * gridDim.z;
    unsigned sum, cnt, mine, sp = 0u;
    for (;;) {
        sum = 0u; cnt = 0u; mine = 0u;
#pragma unroll
        for (unsigned j = 0; j < 16; ++j) { const unsigned c = xb_ld(&bar[XB_XCNT(j)]); sum += c; cnt += (c > 0u) ? 1u : 0u; mine = (j == x) ? c : mine; }
        if (sum == G) break;
        __builtin_amdgcn_s_sleep(1);
        if ((++sp & 255u) == 0u) { if (xb_ld(&bar[XB_TMO])) break; if (sp > XB_SPIN_CAP) { atomicAdd(&bar[XB_TMO], 1u); break; } }
    }
    nloc = mine > 0u ? mine : 1u; nx = cnt > 0u ? cnt : 1u;
}

__device__ __forceinline__ void xcd_barrier(const XcdBarrier& b) {
    asm volatile("s_waitcnt vmcnt(0)" ::: "memory");
    __syncthreads();
    if (threadIdx.x == 0) {
        unsigned* bar = b.bar;
        __builtin_amdgcn_s_waitcnt(0);
        unsigned nloc = b.st[0], nx = b.st[1];
        if (nloc == 0u) { xcd_barrier_complete(bar, b.x, nloc, nx); b.st[0] = nloc; b.st[1] = nx; }
        const unsigned old = xb_add(&bar[XB_XSUB(b.x)], 1u);
        const unsigned gen = old / nloc;
        if (old + 1u == (gen + 1u) * nloc) {
            __builtin_amdgcn_fence(__ATOMIC_RELEASE, "agent");
            asm volatile("s_waitcnt vmcnt(0)" ::: "memory");
            const unsigned og = xb_add(&bar[XB_TOP], 1u);
            const unsigned tg = og / nx;
            if (og + 1u == (tg + 1u) * nx) xb_add(&bar[XB_TOPGEN], 1u);
            else XB_SPIN(xb_ld(&bar[XB_TOPGEN]) == tg, bar);
            __builtin_amdgcn_fence(__ATOMIC_ACQUIRE, "agent");
            xb_add(&bar[XB_XGEN(b.x)], 1u);
            asm volatile("s_waitcnt vmcnt(0)" ::: "memory");
        } else {
            XB_SPIN(xb_ld(&bar[XB_XGEN(b.x)]) == gen, bar);
            __builtin_amdgcn_fence(__ATOMIC_ACQUIRE, "agent");
            asm volatile("s_waitcnt vmcnt(0)" ::: "memory");
        }
    }
    __syncthreads();
}
constexpr int NWAVES = 8;
constexpr int DM = 2048, NB = 4, SEQ = 4096, NTOK = NB * SEQ;
constexpr int LPAD = 4224, LROWS = NB * LPAD;
constexpr int NIN = 6144;
constexpr int C_RQ = 0, C_RK = 512, C_RV = 1024, C_RG = 2048, C_DQ = 3072, C_DK = 4096, C_DV = 5120;
constexpr int NEXP = 64, FF = 512, NPOS = 4112;
constexpr float EPS = 1e-6f;
constexpr float QK_SCALE = 0.08838834764831845f;
constexpr float LOG2E = 1.4426950408889634f;
constexpr float LAMBDA_INIT = 0.2f;
constexpr int MAXSLOT = 49152;

constexpr size_t MiB = 1u << 20;
constexpr size_t WS_CTL = 0, CTL_ZERO_BYTES = 1 * MiB;
constexpr size_t WS_TAB_RET = 1 * MiB;
constexpr size_t WS_TAB_DIFF = 4 * MiB;
constexpr size_t WS_MISC = 5 * MiB;
constexpr size_t WS_WR = 6 * MiB;
constexpr size_t WS_LIST = 8 * MiB, WS_WL = 12 * MiB, WS_TOKSLOT = 16 * MiB;
constexpr size_t WS_WIN = 20 * MiB, WS_WOUT = 44 * MiB, WS_WGU = 52 * MiB, WS_WD = 308 * MiB;
constexpr size_t WS_U = 436 * MiB, WS_MIXED = 500 * MiB, WS_P = 564 * MiB, WS_KV = 762 * MiB, WS_S = 826 * MiB, WS_END = 858 * MiB;
constexpr size_t WS_Y = WS_P, WS_HACT = WS_KV;
static_assert(WS_P + (size_t)LROWS * NIN * 2 <= WS_KV && WS_Y + (size_t)MAXSLOT * DM * 2 <= WS_KV && WS_HACT + (size_t)MAXSLOT * FF * 2 <= WS_S, "ws map");
constexpr int CW_TMO = 0, CW_CODE = 1, CW_BAR = 4096, CW_CNT = 8192  , CW_SS = 16384  ;
static_assert((CW_SS + NTOK) * 4 <= (int)CTL_ZERO_BYTES, "ctl");

constexpr int RING_BYTES = 131072;
constexpr int MOE_TAB_OFF = RING_BYTES;
constexpr int MOE_ROWTAB_OFF = MOE_TAB_OFF + 1024;
constexpr int LDSCTL_OFF = MOE_ROWTAB_OFF + 8 * 1024, MISC_OFF = LDSCTL_OFF + 320;
constexpr int LDS_BYTES = 147456;
static_assert(MISC_OFF + 128 <= LDS_BYTES, "LDS map");

typedef unsigned u32x4 __attribute__((ext_vector_type(4)));
typedef unsigned u32x2 __attribute__((ext_vector_type(2)));
typedef float f32x2 __attribute__((ext_vector_type(2)));
typedef short s16x4 __attribute__((ext_vector_type(4)));

__device__ __forceinline__ unsigned cvtpk(float lo, float hi) { return pg8::cvt_pk_bf16(lo, hi); }
__device__ __forceinline__ float bf_lo(unsigned w) { return __uint_as_float(w << 16); }
__device__ __forceinline__ float bf_hi(unsigned w) { return __uint_as_float(w & 0xffff0000u); }
__device__ __forceinline__ float wave_sum(float v) {
#pragma unroll
    for (int o = 1; o < 64; o <<= 1) v += __shfl_xor(v, o);
    return v;
}
__device__ __forceinline__ float xmax16(float v) { auto r = __builtin_amdgcn_permlane16_swap(__float_as_uint(v), __float_as_uint(v), false, false); return fmaxf(__uint_as_float(r[0]), __uint_as_float(r[1])); }
__device__ __forceinline__ float xmax32(float v) { auto r = __builtin_amdgcn_permlane32_swap(__float_as_uint(v), __float_as_uint(v), false, false); return fmaxf(__uint_as_float(r[0]), __uint_as_float(r[1])); }
__device__ __forceinline__ float xsum16(float v) { auto r = __builtin_amdgcn_permlane16_swap(__float_as_uint(v), __float_as_uint(v), false, false); return __uint_as_float(r[0]) + __uint_as_float(r[1]); }
__device__ __forceinline__ float xsum32(float v) { auto r = __builtin_amdgcn_permlane32_swap(__float_as_uint(v), __float_as_uint(v), false, false); return __uint_as_float(r[0]) + __uint_as_float(r[1]); }

struct Frame {
    LAS unsigned char* lds;
    volatile LAS unsigned* MISC;
    gu32* ctl;
    int tid, lane, wave, G, gw, ngw;
    unsigned char* ws;
    const float* in[17];
    float* out;
};
__device__ __forceinline__ void sincos_d(double a, float& s, float& c) {
    const double k = __builtin_rint(a * 0.63661977236758134308);
    double r = __builtin_fma(-k, 1.57079632679489655800e+00, a);
    r = __builtin_fma(-k, 6.12323399573676603587e-17, r);
    const double r2 = r * r;
    double sp = 1.0 / 6227020800.0; sp = __builtin_fma(sp, r2, -1.0 / 39916800.0); sp = __builtin_fma(sp, r2, 1.0 / 362880.0); sp = __builtin_fma(sp, r2, -1.0 / 5040.0);
    sp = __builtin_fma(sp, r2, 1.0 / 120.0); sp = __builtin_fma(sp, r2, -1.0 / 6.0); sp = __builtin_fma(sp * r2, r, r);
    double cp = -1.0 / 87178291200.0; cp = __builtin_fma(cp, r2, 1.0 / 479001600.0); cp = __builtin_fma(cp, r2, -1.0 / 3628800.0); cp = __builtin_fma(cp, r2, 1.0 / 40320.0);
    cp = __builtin_fma(cp, r2, -1.0 / 720.0); cp = __builtin_fma(cp, r2, 1.0 / 24.0); cp = __builtin_fma(cp, r2, -0.5); cp = __builtin_fma(cp, r2, 1.0);
    const int q = ((int)k) & 3;
    const double sv = (q == 0) ? sp : (q == 1) ? cp : (q == 2) ? -sp : -cp;
    const double cv = (q == 0) ? cp : (q == 1) ? -sp : (q == 2) ? -cp : sp;
    s = (float)sv; c = (float)cv;
}
__host__ __device__ __forceinline__ int win_dest(int n) {
    if (n < 1024) { const int tile = n >> 8, head2 = (n >> 7) & 1, d = n & 127; return tile * 256 + (d < 64 ? head2 * 64 + d : 128 + head2 * 64 + (d - 64)); }
    if (n >= C_DQ && n < C_DV) { const int tile = n >> 8, comp = (n >> 7) & 1, d = n & 127;
        return tile * 256 + (d < 16 ? comp * 16 + d : d < 32 ? 128 + comp * 16 + (d - 16) : comp * 128 + d); }
    return n;
}
template <int MODE  > __device__ __forceinline__ void tr_item(const float* __restrict__ W, int N, bf16* __restrict__ WT, int K, int k0, int n0, int lane) {
    const float* src = W + (size_t)k0 * N + n0 + 4 * lane;
    f32x4 v[8];
#pragma unroll
    for (int j = 0; j < 8; ++j) v[j] = *(const f32x4*)(src + (size_t)j * N);
    const int n = n0 + 4 * lane;
    const int drow = MODE == 0 ? n : MODE == 1 ? win_dest(n) : MODE == 2 ? ((n >> 7) * 256 + (n & 127)) : ((n >> 7) * 256 + 128 + (n & 127));
#pragma unroll
    for (int jj = 0; jj < 4; ++jj) {
        u32x4 o; o.x = cvtpk(v[0][jj], v[1][jj]); o.y = cvtpk(v[2][jj], v[3][jj]); o.z = cvtpk(v[4][jj], v[5][jj]); o.w = cvtpk(v[6][jj], v[7][jj]);
        *(u32x4*)(WT + (size_t)(drow + jj) * K + k0) = o;
    }
}
__device__ __forceinline__ void rms_row_to_bf16(const float* __restrict__ xrow, const float* __restrict__ g, bf16* __restrict__ orow, int lane) {
    const f32x4* xr = (const f32x4*)xrow + lane; f32x4 v[8]; float s = 0.f;
#pragma unroll
    for (int j = 0; j < 8; ++j) { v[j] = xr[64 * j]; s += (v[j].x * v[j].x + v[j].y * v[j].y) + (v[j].z * v[j].z + v[j].w * v[j].w); }
    const float r = 1.0f / sqrtf(wave_sum(s) * (1.f / DM) + EPS);
    u32x2* o8 = (u32x2*)orow + lane;
#pragma unroll
    for (int j = 0; j < 8; ++j) { const f32x4 gg = ((const f32x4*)g)[lane + 64 * j]; u32x2 w; w.x = cvtpk(v[j].x * r * gg.x, v[j].y * r * gg.y); w.y = cvtpk(v[j].z * r * gg.z, v[j].w * r * gg.w); o8[64 * j] = w; }
}
__device__ __forceinline__ void p0_prologue(Frame& F) {
    unsigned char* ws = F.ws;
    const int gt = F.gw * 64 + F.lane, ngt = F.ngw * 64;
    { f32x2* tr = (f32x2*)(ws + WS_TAB_RET); f32x2* td = (f32x2*)(ws + WS_TAB_DIFF);
      for (int e = gt; e < NPOS * 80; e += ngt) { const int pos = e / 80, i = e - pos * 80;
        float inv; if (i < 64) inv = 1.0f / __builtin_amdgcn_exp2f((float)i * (13.287712379549449f / 63.0f)); else inv = __builtin_amdgcn_exp2f(-(float)(i - 64) * (18.931568569324174f / 16.0f));
        const float ang = (float)pos * inv; float s, c; sincos_d((double)ang, s, c);
        if (i < 64) tr[pos * 64 + i] = (f32x2){c, s}; else td[pos * 16 + (i - 64)] = (f32x2){c, s}; } }
    if (gt == 0) { float a = 0.f, b = 0.f; for (int i = 0; i < 128; ++i) { a += F.in[5][i] * F.in[6][i]; b += F.in[7][i] * F.in[8][i]; }
        *(float*)(ws + WS_MISC) = expf(a) - expf(b) + LAMBDA_INIT; }
    { bf16* wr = (bf16*)(ws + WS_WR);
      for (int e = gt; e < 80 * DM; e += ngt) { const int n = e >> 11, k = e & 2047; const float v = n < 64 ? F.in[12][(size_t)k * 64 + n] : n < 72 ? F.in[11][(size_t)k * 8 + (n - 64)] : 0.f;
        const unsigned h = f2bf(v); const float hv = __uint_as_float(h << 16); wr[e] = (bf16)h; wr[80 * DM + e] = (bf16)f2bf(v - hv); } }
    { u32x4* P4 = (u32x4*)(ws + WS_P);
      for (int e = gt; e < NB * 112 * 768; e += ngt) { const int r = e / 768, ch = e - r * 768, b = r / 112, l = r - b * 112; P4[(size_t)(b * LPAD + l) * 768 + ch] = (u32x4){0u, 0u, 0u, 0u}; } }
    for (int m = F.gw; m < 16; m += F.ngw) rms_row_to_bf16(F.in[1] + (size_t)m * DM, F.in[2], (bf16*)(ws + WS_MISC + 4096) + (size_t)m * DM, F.lane);
    for (int m = F.gw; m < NTOK; m += F.ngw) rms_row_to_bf16(F.in[0] + (size_t)m * DM, F.in[2], (bf16*)(ws + WS_U) + (size_t)m * DM, F.lane);
    constexpr int I_IN = 256 * 24, I_OUT = 256 * 8, I_G = 64 * 512, I_U = 64 * 512, I_D = 64 * 512;
    for (int it = F.gw; it < I_IN + I_OUT + I_G + I_U + I_D; it += F.ngw) {
        int r = it;
        if (r < I_IN) { tr_item<1>(F.in[3], NIN, (bf16*)(ws + WS_WIN), DM, (r / 24) * 8, (r % 24) * 256, F.lane); continue; } r -= I_IN;
        if (r < I_OUT) { tr_item<0>(F.in[4], DM, (bf16*)(ws + WS_WOUT), DM, (r / 8) * 8, (r % 8) * 256, F.lane); continue; } r -= I_OUT;
        if (r < I_G) { const int e = r >> 9, q = r & 511; tr_item<2>(F.in[13] + (size_t)e * DM * FF, FF, (bf16*)(ws + WS_WGU) + (size_t)e * 1024 * DM, DM, (q >> 1) * 8, (q & 1) * 256, F.lane); continue; } r -= I_G;
        if (r < I_U) { const int e = r >> 9, q = r & 511; tr_item<3>(F.in[14] + (size_t)e * DM * FF, FF, (bf16*)(ws + WS_WGU) + (size_t)e * 1024 * DM, DM, (q >> 1) * 8, (q & 1) * 256, F.lane); continue; } r -= I_U;
        { const int e = r >> 9, q = r & 511; tr_item<0>(F.in[15] + (size_t)e * FF * DM, DM, (bf16*)(ws + WS_WD) + (size_t)e * DM * FF, FF, (q >> 3) * 8, (q & 7) * 256, F.lane); }
    }
}
__host__ __device__ __forceinline__ int tile_type(int pn) { return pn < 2 ? 0 : pn < 4 ? 1 : pn < 12 ? 2 : pn < 16 ? 3 : pn < 20 ? 4 : 2; }
struct EpiProj {
    static constexpr bool PERM = true;
    bf16* P; const f32x2* tret; const f32x2* tdiff;
    __device__ __forceinline__ void operator()(const f32x4 (&acc)[2][2][4][2], const pg8::Unit& u, int wr, int wc, int fr, int fq) const {
        const int ty = tile_type(u.pn), G = 4 * wc + fq;
        const float sc = ty == 1 ? QK_SCALE : ty == 3 ? QK_SCALE * LOG2E : 1.f;
        const bool rot = (ty == 0 || ty == 1) || ((ty == 3 || ty == 4) && wc == 0);
        const bool full = ty < 2;
        const int i0 = full ? 8 * (G & 7) : 8 * (fq & 1);
        const int d1 = full ? (G >> 3) * 128 + i0 : (fq >> 1) * 128 + i0, d2 = full ? d1 + 64 : d1 + 16;
#pragma unroll
        for (int ai = 0; ai < 2; ++ai)
#pragma unroll
            for (int m = 0; m < 4; ++m) {
                const int R = u.pm * 256 + ai * 128 + wr * 64 + m * 16 + fr, b = R >> 12, t = R & 4095;
                bf16* rowp = P + (size_t)(R + 128 * (b + 1)) * NIN + u.pn * 256;
                const f32x4 a0 = acc[ai][0][m][0], a1 = acc[ai][0][m][1], b0 = acc[ai][1][m][0], b1 = acc[ai][1][m][1];
                if (rot) {
                    const f32x4* cs = (const f32x4*)((full ? tret + (size_t)(16 + t) * 64 : tdiff + (size_t)(16 + t) * 16) + i0);
                    const f32x4 c01 = cs[0], c23 = cs[1], c45 = cs[2], c67 = cs[3];
                    u32x4 o1, o2;
#define ROT1(x1, x2, c, s) (((x1) * (c) - (x2) * (s)) * sc)
#define ROT2(x1, x2, c, s) (((x1) * (s) + (x2) * (c)) * sc)
                    o1.x = cvtpk(ROT1(a0[0], b0[0], c01[0], c01[1]), ROT1(a0[1], b0[1], c01[2], c01[3])); o1.y = cvtpk(ROT1(a0[2], b0[2], c23[0], c23[1]), ROT1(a0[3], b0[3], c23[2], c23[3]));
                    o1.z = cvtpk(ROT1(a1[0], b1[0], c45[0], c45[1]), ROT1(a1[1], b1[1], c45[2], c45[3])); o1.w = cvtpk(ROT1(a1[2], b1[2], c67[0], c67[1]), ROT1(a1[3], b1[3], c67[2], c67[3]));
                    o2.x = cvtpk(ROT2(a0[0], b0[0], c01[0], c01[1]), ROT2(a0[1], b0[1], c01[2], c01[3])); o2.y = cvtpk(ROT2(a0[2], b0[2], c23[0], c23[1]), ROT2(a0[3], b0[3], c23[2], c23[3]));
                    o2.z = cvtpk(ROT2(a1[0], b1[0], c45[0], c45[1]), ROT2(a1[1], b1[1], c45[2], c45[3])); o2.w = cvtpk(ROT2(a1[2], b1[2], c67[0], c67[1]), ROT2(a1[3], b1[3], c67[2], c67[3]));
#undef ROT1
#undef ROT2
                    *(u32x4*)(rowp + d1) = o1; *(u32x4*)(rowp + d2) = o2;
                } else {
                    u32x4 o1, o2;
                    o1.x = cvtpk(a0[0] * sc, a0[1] * sc); o1.y = cvtpk(a0[2] * sc, a0[3] * sc); o1.z = cvtpk(a1[0] * sc, a1[1] * sc); o1.w = cvtpk(a1[2] * sc, a1[3] * sc);
                    o2.x = cvtpk(b0[0] * sc, b0[1] * sc); o2.y = cvtpk(b0[2] * sc, b0[3] * sc); o2.z = cvtpk(b1[0] * sc, b1[1] * sc); o2.w = cvtpk(b1[2] * sc, b1[3] * sc);
                    *(u32x4*)(rowp + 8 * G) = o1; *(u32x4*)(rowp + 128 + 8 * G) = o2;
                }
            }
    }
};
__device__ __forceinline__ void meta_proj_task(Frame& F, int task) {
    const int lane = F.lane, g = lane >> 4, li = lane & 15;
    const int tsel = task >> 3, j8 = task & 7;
    const int pn = tsel < 2 ? 2 + tsel : tsel < 6 ? 4 + (tsel - 2) : 16 + (tsel - 6);
    const bf16* um = (const bf16*)(F.ws + WS_MISC + 4096);
    const bf16* wt = (const bf16*)(F.ws + WS_WIN);
    const bf16* ap = um + (size_t)li * DM + 8 * g;
    const bf16* bp0 = wt + (size_t)(pn * 256 + 16 * j8 + li) * DM + 8 * g;
    const bf16* bp1 = bp0 + (size_t)128 * DM;
    f32x4 accA = {0.f, 0.f, 0.f, 0.f}, accB = {0.f, 0.f, 0.f, 0.f};
#pragma unroll 4
    for (int s = 0; s < 64; ++s) {
        const bf16x8 a = *(const bf16x8*)(ap + 32 * s), b0 = *(const bf16x8*)(bp0 + 32 * s), b1 = *(const bf16x8*)(bp1 + 32 * s);
        accA = __builtin_amdgcn_mfma_f32_16x16x32_bf16(a, b0, accA, 0, 0, 0);
        accB = __builtin_amdgcn_mfma_f32_16x16x32_bf16(a, b1, accB, 0, 0, 0);
    }
    const int ty = tile_type(pn), c = 16 * j8 + li;
    const f32x2* tret = (const f32x2*)(F.ws + WS_TAB_RET); const f32x2* tdiff = (const f32x2*)(F.ws + WS_TAB_DIFF);
    bf16* P = (bf16*)(F.ws + WS_P);
#pragma unroll
    for (int r = 0; r < 4; ++r) {
        const int row = 4 * g + r;
        float x1 = accA[r], x2 = accB[r]; int c1 = c, c2 = 128 + c;
        if (ty == 1) { const int head2 = c >> 6, i = c & 63; const f32x2 cs = tret[row * 64 + i]; const float y1 = (x1 * cs.x - x2 * cs.y) * QK_SCALE, y2 = (x1 * cs.y + x2 * cs.x) * QK_SCALE;
            x1 = y1; x2 = y2; c1 = head2 * 128 + i; c2 = c1 + 64; }
        else if (ty == 4 && c < 32) { const int comp = c >> 4, i = c & 15; const f32x2 cs = tdiff[row * 16 + i]; const float y1 = x1 * cs.x - x2 * cs.y, y2 = x1 * cs.y + x2 * cs.x;
            x1 = y1; x2 = y2; c1 = comp * 128 + i; c2 = c1 + 16; }
        const bf16 h1 = (bf16)f2bf(x1), h2 = (bf16)f2bf(x2);
#pragma unroll
        for (int b = 0; b < NB; ++b) { bf16* rowp = P + (size_t)(b * LPAD + 112 + row) * NIN + pn * 256; rowp[c1] = h1; rowp[c2] = h2; }
    }
}
struct EpiH1 {
    static constexpr bool PERM = false;
    const float* x; float* out; float* ss;
    __device__ __forceinline__ void operator()(const f32x4 (&acc)[2][2][4][2], const pg8::Unit& u, int wr, int wc, int fr, int fq) const {
        const int col0 = u.pn * 256 + wc * 32 + 4 * fq;
#pragma unroll
        for (int ai = 0; ai < 2; ++ai)
#pragma unroll
            for (int m = 0; m < 4; ++m) {
                const int R = u.pm * 256 + ai * 128 + wr * 64 + m * 16 + fr; const size_t off = (size_t)R * DM + col0; float s = 0.f;
#pragma unroll
                for (int bj = 0; bj < 2; ++bj)
#pragma unroll
                    for (int n = 0; n < 2; ++n) { const f32x4 h = *(const f32x4*)(x + off + bj * 128 + n * 16) + acc[ai][bj][m][n]; *(f32x4*)(out + off + bj * 128 + n * 16) = h;
                        s += (h[0] * h[0] + h[1] * h[1]) + (h[2] * h[2] + h[3] * h[3]); }
                s += __shfl_xor(s, 16); s += __shfl_xor(s, 32);
                if (fq == 0) atomicAdd(ss + R, s);
            }
    }
};
struct MoeSched {
    const LAS int* tb; const LAS int* cnt; const LAS unsigned* rowtab; int NT, G, c;
    __device__ __forceinline__ int expert_of(int T) const { int e = 0;
#pragma unroll
        for (int s = 32; s > 0; s >>= 1) if (tb[e + s] <= T) e += s;
        return e; }
    __device__ __forceinline__ bool next(int i, pg8::Unit& u) const {
        const int L = i * G + c; if (L >= tb[64] * NT) return false;
        const int T = L / NT, nt = L - T * NT; u.pm = T; u.pn = expert_of(T) * NT + nt; u.aux = i; return true; }
    __device__ __forceinline__ unsigned rowoff(const pg8::Unit& u, int row) const { return rowtab[u.aux * 256 + row]; }
};
__device__ __forceinline__ float silu_f(float g) { return g * __builtin_amdgcn_rcpf(1.0f + __builtin_amdgcn_exp2f(-g * LOG2E)); }
struct EpiAct {
    static constexpr bool PERM = true;
    bf16* H;
    __device__ __forceinline__ void operator()(const f32x4 (&acc)[2][2][4][2], const pg8::Unit& u, int wr, int wc, int fr, int fq) const {
        const int nt = u.pn & 3, G = 4 * wc + fq;
#pragma unroll
        for (int ai = 0; ai < 2; ++ai)
#pragma unroll
            for (int m = 0; m < 4; ++m) {
                const int row = u.pm * 256 + ai * 128 + wr * 64 + m * 16 + fr;
                const f32x4 g0 = acc[ai][0][m][0], g1 = acc[ai][0][m][1], u0 = acc[ai][1][m][0], u1 = acc[ai][1][m][1];
                u32x4 o; o.x = cvtpk(silu_f(g0[0]) * u0[0], silu_f(g0[1]) * u0[1]); o.y = cvtpk(silu_f(g0[2]) * u0[2], silu_f(g0[3]) * u0[3]);
                o.z = cvtpk(silu_f(g1[0]) * u1[0], silu_f(g1[1]) * u1[1]); o.w = cvtpk(silu_f(g1[2]) * u1[2], silu_f(g1[3]) * u1[3]);
                *(u32x4*)(H + (size_t)row * FF + nt * 128 + 8 * G) = o;
            }
    }
};
struct EpiY {
    static constexpr bool PERM = true;
    bf16* Y; const float* wl; const LAS int* tb; const LAS int* cnt;
    __device__ __forceinline__ void operator()(const f32x4 (&acc)[2][2][4][2], const pg8::Unit& u, int wr, int wc, int fr, int fq) const {
        const int e = u.pn >> 3, nt = u.pn & 7, G = 4 * wc + fq, r0 = (u.pm - tb[e]) * 256, ce = cnt[e];
#pragma unroll
        for (int ai = 0; ai < 2; ++ai)
#pragma unroll
            for (int m = 0; m < 4; ++m) {
                const int rt = ai * 128 + wr * 64 + m * 16 + fr, r = r0 + rt;
                const float w = r < ce ? wl[(size_t)e * NTOK + r] : 0.f;
                bf16* rowp = Y + (size_t)(u.pm * 256 + rt) * DM + nt * 256 + 8 * G;
#pragma unroll
                for (int bj = 0; bj < 2; ++bj) { const f32x4 v0 = acc[ai][bj][m][0], v1 = acc[ai][bj][m][1];
                    u32x4 o; o.x = cvtpk(v0[0] * w, v0[1] * w); o.y = cvtpk(v0[2] * w, v0[3] * w); o.z = cvtpk(v1[0] * w, v1[1] * w); o.w = cvtpk(v1[2] * w, v1[3] * w);
                    *(u32x4*)(rowp + bj * 128) = o; }
            }
    }
};
constexpr int AT_KS = 528, AT_VS = 544, AT_KB = 32 * AT_KS, AT_VB = 32 * AT_VS, AT_BUF = AT_KB + AT_VB, AT_SCR = 2 * AT_BUF;
static_assert(AT_SCR + NWAVES * 256 <= RING_BYTES, "attention LDS");
typedef short v4i16_t __attribute__((ext_vector_type(4)));
__device__ __forceinline__ s16x4 trr(const LAS unsigned char* p) { return __builtin_bit_cast(s16x4, __builtin_amdgcn_ds_read_tr16_b64_v4i16((LAS v4i16_t*)p)); }
#define MFMA16(a, b, c) __builtin_amdgcn_mfma_f32_16x16x32_bf16(a, b, c, 0, 0, 0)
#define BV8(lo, hi) (bf16x8){lo[0], lo[1], lo[2], lo[3], hi[0], hi[1], hi[2], hi[3]}
__device__ __forceinline__ float fexp2(float x) { return __builtin_amdgcn_exp2f(x); }

__device__ __forceinline__ void sm16(f32x4 (&s)[2], float& m, float& l, float& alpha, bf16x8& pa) {
    float mx = fmaxf(fmaxf(fmaxf(s[0][0], s[0][1]), fmaxf(s[0][2], s[0][3])), fmaxf(fmaxf(s[1][0], s[1][1]), fmaxf(s[1][2], s[1][3])));
    mx = xmax32(xmax16(mx));
    const float mn = fmaxf(m, mx); alpha = fexp2(m - mn); m = mn;
    float ps = 0.f;
#pragma unroll
    for (int kb = 0; kb < 2; ++kb)
#pragma unroll
        for (int r = 0; r < 4; ++r) { s[kb][r] = fexp2(s[kb][r] - mn); ps += s[kb][r]; }
    l = l * alpha + ps;
    u32x4 w; w.x = cvtpk(s[0][0], s[0][1]); w.y = cvtpk(s[0][2], s[0][3]); w.z = cvtpk(s[1][0], s[1][1]); w.w = cvtpk(s[1][2], s[1][3]);
    pa = __builtin_bit_cast(bf16x8, w);
}

__device__ __forceinline__ void diff_unit(Frame& F, int b, int h, int qb) {
    LAS unsigned char* lds = F.lds;
    const int tid = F.tid, lane = F.lane, w = F.wave, g = lane >> 4, li = lane & 15;
    const bf16* Pb = (const bf16*)(F.ws + WS_P) + (size_t)b * LPAD * NIN;
    const int Q0 = 128 + 128 * qb, qpos = Q0 + 16 * w + li;
    bf16x8 qf[2][4];
    { const bf16* qp = Pb + (size_t)qpos * NIN + C_DQ + h * 256 + 8 * g;
#pragma unroll
      for (int cp = 0; cp < 2; ++cp)
#pragma unroll
          for (int s = 0; s < 4; ++s) qf[cp][s] = *(const bf16x8*)(qp + cp * 128 + 32 * s); }
    const int srow = tid >> 5, sch = tid & 31;
    const bf16* kg = Pb + (size_t)srow * NIN + C_DK + h * 256 + sch * 8;
    const bf16* vg = Pb + (size_t)srow * NIN + C_DV + h * 256 + sch * 8;
    const int kst = srow * AT_KS + sch * 16, vst = AT_KB + srow * AT_VS + sch * 16;
    const int kra = li * AT_KS + g * 16;
    const int vra = AT_KB + (4 * g + (li >> 2)) * AT_VS + (li & 3) * 8;
    u32x4 st[4];
    float m1 = -1e30f, m2 = -1e30f, l1 = 0.f, l2 = 0.f;
    {
#define P1_LOAD(l0) do { _Pragma("unroll") for (int i_ = 0; i_ < 4; ++i_) st[i_] = *(const u32x4*)(kg + (size_t)((l0) + 16 * i_) * NIN); } while (0)
#define P1_WRITE(bf) do { LAS unsigned char* d_ = lds + (bf) * AT_BUF; _Pragma("unroll") for (int i_ = 0; i_ < 4; ++i_) *(LAS u32x4*)(d_ + kst + 16 * i_ * AT_KS) = st[i_]; } while (0)
        const int nt1 = 3 + 2 * qb;
        P1_LOAD(64); P1_WRITE(0); P1_LOAD(128); __syncthreads();
        for (int j = 0; j < nt1; ++j) {
            const int l0 = 64 + 64 * j; const LAS unsigned char* tb = lds + (j & 1) * AT_BUF;
            f32x4 s1[4], s2[4];
#pragma unroll
            for (int kb = 0; kb < 4; ++kb) { s1[kb] = (f32x4){0.f, 0.f, 0.f, 0.f}; s2[kb] = (f32x4){0.f, 0.f, 0.f, 0.f};
#pragma unroll
                for (int s = 0; s < 4; ++s) { const bf16x8 a1 = *(const LAS bf16x8*)(tb + kra + kb * 16 * AT_KS + s * 64), a2 = *(const LAS bf16x8*)(tb + kra + kb * 16 * AT_KS + 256 + s * 64);
                    s1[kb] = MFMA16(a1, qf[0][s], s1[kb]); s2[kb] = MFMA16(a2, qf[1][s], s2[kb]); } }
            if (j == 0 || l0 >= Q0) {
#pragma unroll
                for (int kb = 0; kb < 4; ++kb)
#pragma unroll
                    for (int r = 0; r < 4; ++r) { const int key = l0 + 16 * kb + 4 * g + r; if (key < 112 || key > qpos) { s1[kb][r] = -1e30f; s2[kb][r] = -1e30f; } }
            }
            if (j + 1 < nt1) P1_WRITE((j + 1) & 1);
            if (j + 2 < nt1) P1_LOAD(l0 + 128);
            { float mx = m1;
#pragma unroll
              for (int kb = 0; kb < 4; ++kb) mx = fmaxf(fmaxf(mx, fmaxf(s1[kb][0], s1[kb][1])), fmaxf(s1[kb][2], s1[kb][3]));
              float ps = 0.f;
#pragma unroll
              for (int kb = 0; kb < 4; ++kb)
#pragma unroll
                  for (int r = 0; r < 4; ++r) ps += fexp2(s1[kb][r] - mx);
              l1 = l1 * fexp2(m1 - mx) + ps; m1 = mx; }
            { float mx = m2;
#pragma unroll
              for (int kb = 0; kb < 4; ++kb) mx = fmaxf(fmaxf(mx, fmaxf(s2[kb][0], s2[kb][1])), fmaxf(s2[kb][2], s2[kb][3]));
              float ps = 0.f;
#pragma unroll
              for (int kb = 0; kb < 4; ++kb)
#pragma unroll
                  for (int r = 0; r < 4; ++r) ps += fexp2(s2[kb][r] - mx);
              l2 = l2 * fexp2(m2 - mx) + ps; m2 = mx; }
            __syncthreads();
        }
#undef P1_LOAD
#undef P1_WRITE
    }
    { const float M1 = xmax32(xmax16(m1)), M2 = xmax32(xmax16(m2));
      l1 = xsum32(xsum16(l1 * fexp2(m1 - M1))); l2 = xsum32(xsum16(l2 * fexp2(m2 - M2))); m1 = M1; m2 = M2; }
    const float i1 = 1.0f / l1, i2 = *(const float*)(F.ws + WS_MISC) / l2;
    f32x4 o[16];
#pragma unroll
    for (int c = 0; c < 16; ++c) o[c] = (f32x4){0.f, 0.f, 0.f, 0.f};
    {
#define D_LOADT(l0) do { const size_t o_ = (size_t)(l0) * NIN; st[0] = *(const u32x4*)(kg + o_); st[1] = *(const u32x4*)(kg + o_ + 16 * NIN); st[2] = *(const u32x4*)(vg + o_); st[3] = *(const u32x4*)(vg + o_ + 16 * NIN); } while (0)
#define D_WRITET(bf) do { LAS unsigned char* d_ = lds + (bf) * AT_BUF; *(LAS u32x4*)(d_ + kst) = st[0]; *(LAS u32x4*)(d_ + kst + 16 * AT_KS) = st[1]; *(LAS u32x4*)(d_ + vst) = st[2]; *(LAS u32x4*)(d_ + vst + 16 * AT_VS) = st[3]; } while (0)
        const int ntiles = 5 + 4 * qb;
        D_LOADT(96); D_WRITET(0); D_LOADT(128); __syncthreads();
        for (int j = 0; j < ntiles; ++j) {
            const int l0 = 96 + 32 * j; const LAS unsigned char* tb = lds + (j & 1) * AT_BUF;
            f32x4 s1[2], s2[2];
#pragma unroll
            for (int kb = 0; kb < 2; ++kb) { s1[kb] = (f32x4){0.f, 0.f, 0.f, 0.f}; s2[kb] = (f32x4){0.f, 0.f, 0.f, 0.f};
#pragma unroll
                for (int s = 0; s < 4; ++s) { const bf16x8 a1 = *(const LAS bf16x8*)(tb + kra + kb * 16 * AT_KS + s * 64), a2 = *(const LAS bf16x8*)(tb + kra + kb * 16 * AT_KS + 256 + s * 64);
                    s1[kb] = MFMA16(a1, qf[0][s], s1[kb]); s2[kb] = MFMA16(a2, qf[1][s], s2[kb]); } }
            if (j == 0 || l0 >= Q0) {
#pragma unroll
                for (int kb = 0; kb < 2; ++kb)
#pragma unroll
                    for (int r = 0; r < 4; ++r) { const int key = l0 + 16 * kb + 4 * g + r; if (key < 112 || key > qpos) { s1[kb][r] = -1e30f; s2[kb][r] = -1e30f; } }
            }
#pragma unroll
            for (int kb = 0; kb < 2; ++kb)
#pragma unroll
                for (int r = 0; r < 4; ++r) s1[kb][r] = fexp2(s1[kb][r] - m1) * i1 - fexp2(s2[kb][r] - m2) * i2;
            u32x4 pw; pw.x = cvtpk(s1[0][0], s1[0][1]); pw.y = cvtpk(s1[0][2], s1[0][3]); pw.z = cvtpk(s1[1][0], s1[1][1]); pw.w = cvtpk(s1[1][2], s1[1][3]);
            const bf16x8 pa = __builtin_bit_cast(bf16x8, pw);
            if (j + 1 < ntiles) D_WRITET((j + 1) & 1);
            if (j + 2 < ntiles) D_LOADT(l0 + 64);
#pragma unroll
            for (int c = 0; c < 16; ++c) { const s16x4 lo = trr(tb + vra + c * 32), hi = trr(tb + vra + 16 * AT_VS + c * 32); o[c] = MFMA16(pa, BV8(lo, hi), o[c]); }
            __syncthreads();
        }
#undef D_LOADT
#undef D_WRITET
    }
    f32x4 ss = {0.f, 0.f, 0.f, 0.f};
#pragma unroll
    for (int c = 0; c < 16; ++c) ss += o[c] * o[c];
#pragma unroll
    for (int r = 0; r < 4; ++r) { float v = ss[r]; v += __shfl_xor(v, 1); v += __shfl_xor(v, 2); v += __shfl_xor(v, 4); v += __shfl_xor(v, 8); ss[r] = 1.0f / sqrtf(v * (1.f / 256.f) + EPS); }
    const float* gs = F.in[9];
    bf16* mx = (bf16*)(F.ws + WS_MIXED) + (size_t)(b * SEQ + 128 * qb + 16 * w + 4 * g) * DM + 1024 + h * 256 + li;
#pragma unroll
    for (int c = 0; c < 16; ++c) { const float gv = gs[16 * c + li] * (1.0f - LAMBDA_INIT);
#pragma unroll
        for (int r = 0; r < 4; ++r) mx[(size_t)r * DM + 16 * c] = (bf16)f2bf(o[c][r] * ss[r] * gv); }
}

__device__ __forceinline__ float ret_log2g(int h) { return log2f(1.0f - 1.0f / (float)(32 << h)); }
__device__ __forceinline__ void ret_kv_unit(Frame& F, int b, int h, int c  ) {
    LAS unsigned char* lds = F.lds;
    const int tid = F.tid, lane = F.lane, w = F.wave, g = lane >> 4, li = lane & 15;
    const bf16* Pb = (const bf16*)(F.ws + WS_P) + (size_t)(b * LPAD + 128 * c) * NIN;
    const float lg = ret_log2g(h);
    const int krow = tid >> 4, kch = tid & 15, srow = tid >> 5, sch = tid & 31;
    const bf16* kg = Pb + (size_t)krow * NIN + C_RK + h * 128 + kch * 8;
    const bf16* vg = Pb + (size_t)srow * NIN + C_RV + h * 256 + sch * 8;
    const int kst = krow * AT_KS + kch * 16, vst = AT_KB + srow * AT_VS + sch * 16;
    u32x4 st[3];
#define K_LOADT(i) do { const size_t o_ = (size_t)(32 * (i)) * NIN; st[0] = *(const u32x4*)(kg + o_); st[1] = *(const u32x4*)(vg + o_); st[2] = *(const u32x4*)(vg + o_ + 16 * NIN); } while (0)
#define K_WRITET(bf, i) do { LAS unsigned char* d_ = lds + (bf) * AT_BUF; const float z_ = fexp2((float)(127 - 32 * (i) - krow) * lg); u32x4 k_; \
        k_.x = cvtpk(bf_lo(st[0].x) * z_, bf_hi(st[0].x) * z_); k_.y = cvtpk(bf_lo(st[0].y) * z_, bf_hi(st[0].y) * z_); k_.z = cvtpk(bf_lo(st[0].z) * z_, bf_hi(st[0].z) * z_); k_.w = cvtpk(bf_lo(st[0].w) * z_, bf_hi(st[0].w) * z_); \
        *(LAS u32x4*)(d_ + kst) = k_; *(LAS u32x4*)(d_ + vst) = st[1]; *(LAS u32x4*)(d_ + vst + 16 * AT_VS) = st[2]; } while (0)
    const int ara = (4 * g + (li >> 2)) * AT_KS + (16 * w + 4 * (li & 3)) * 2;
    const int vra = AT_KB + (4 * g + (li >> 2)) * AT_VS + (li & 3) * 8;
    f32x4 acc[16];
#pragma unroll
    for (int cc = 0; cc < 16; ++cc) acc[cc] = (f32x4){0.f, 0.f, 0.f, 0.f};
    K_LOADT(0); K_WRITET(0, 0); K_LOADT(1); __syncthreads();
#pragma unroll
    for (int i = 0; i < 4; ++i) {
        const LAS unsigned char* tb = lds + (i & 1) * AT_BUF;
        const s16x4 alo = trr(tb + ara), ahi = trr(tb + ara + 16 * AT_KS); const bf16x8 af = BV8(alo, ahi);
        if (i + 1 < 4) K_WRITET((i + 1) & 1, i + 1);
        if (i + 2 < 4) K_LOADT(i + 2);
#pragma unroll
        for (int cc = 0; cc < 16; ++cc) { const s16x4 lo = trr(tb + vra + cc * 32), hi = trr(tb + vra + 16 * AT_VS + cc * 32); acc[cc] = MFMA16(af, BV8(lo, hi), acc[cc]); }
        __syncthreads();
    }
#undef K_LOADT
#undef K_WRITET
    float* kv = (float*)(F.ws + WS_KV) + ((size_t)((b * 4 + h) * 32 + c) * 128 + 16 * w + 4 * g) * 256 + li;
#pragma unroll
    for (int cc = 0; cc < 16; ++cc)
#pragma unroll
        for (int r = 0; r < 4; ++r) kv[(size_t)r * 256 + 16 * cc] = acc[cc][r];
}
__device__ __forceinline__ void ret_scan(Frame& F) {
    const int gt = F.gw * 64 + F.lane, ngt = F.ngw * 64;
    for (int e = gt; e < 16 * 128 * 64; e += ngt) {
        const int bh = e >> 13, rem = e & 8191;
        const float dec = fexp2(128.0f * ret_log2g(bh & 3));
        const f32x4* kv = (const f32x4*)(F.ws + WS_KV) + (size_t)bh * 32 * 8192 + rem;
        u32x2* sb = (u32x2*)(F.ws + WS_S) + (size_t)bh * 32 * 8192 + rem;
        f32x4 s = {0.f, 0.f, 0.f, 0.f};
#pragma unroll 8
        for (int c = 0; c < 32; ++c) { s = s * dec + kv[(size_t)c * 8192]; u32x2 o; o.x = cvtpk(s[0], s[1]); o.y = cvtpk(s[2], s[3]); sb[(size_t)c * 8192] = o; }
    }
}
__device__ __forceinline__ void ret_out_unit(Frame& F, int b, int h, int c  ) {
    LAS unsigned char* lds = F.lds;
    const int tid = F.tid, lane = F.lane, w = F.wave, g = lane >> 4, li = lane & 15;
    const bf16* Pb = (const bf16*)(F.ws + WS_P) + (size_t)(b * LPAD + 128 * c) * NIN;
    const bf16* Sb = (const bf16*)(F.ws + WS_S) + (size_t)((b * 4 + h) * 32 + (c - 1)) * 128 * 256;
    const float lg = ret_log2g(h);
    bf16x8 qf[4];
    { const bf16* qp = Pb + (size_t)(16 * w + li) * NIN + C_RQ + h * 128 + 8 * g;
#pragma unroll
      for (int s = 0; s < 4; ++s) qf[s] = *(const bf16x8*)(qp + 32 * s); }
    const int krow = tid >> 4, kch = tid & 15, srow = tid >> 5, sch = tid & 31;
    const int rho = 16 * ((srow >> 2) & 1) + 4 * (srow >> 3) + (srow & 3);
    const bf16* sg = Sb + (size_t)srow * 256 + sch * 8;
    const bf16* kg = Pb + (size_t)krow * NIN + C_RK + h * 128 + kch * 8;
    const bf16* vg = Pb + (size_t)srow * NIN + C_RV + h * 256 + sch * 8;
    const int kst = krow * AT_KS + kch * 16, vst = AT_KB + srow * AT_VS + sch * 16, sst = AT_KB + rho * AT_VS + sch * 16;
    u32x4 st[3];
#define R_LOAD(j) do { if ((j) < 4) { const size_t o_ = (size_t)(32 * (j)) * 256; st[1] = *(const u32x4*)(sg + o_); st[2] = *(const u32x4*)(sg + o_ + 16 * 256); } \
        else { const size_t o_ = (size_t)(32 * ((j) - 4)) * NIN; st[0] = *(const u32x4*)(kg + o_); st[1] = *(const u32x4*)(vg + o_); st[2] = *(const u32x4*)(vg + o_ + 16 * NIN); } } while (0)
#define R_WRITE(bf, j) do { LAS unsigned char* d_ = lds + (bf) * AT_BUF; if ((j) < 4) { *(LAS u32x4*)(d_ + sst) = st[1]; *(LAS u32x4*)(d_ + sst + 8 * AT_VS) = st[2]; } \
        else { *(LAS u32x4*)(d_ + kst) = st[0]; *(LAS u32x4*)(d_ + vst) = st[1]; *(LAS u32x4*)(d_ + vst + 16 * AT_VS) = st[2]; } } while (0)
    const int kra = li * AT_KS + g * 16;
    const int vra = AT_KB + (4 * g + (li >> 2)) * AT_VS + (li & 3) * 8;
    f32x4 o[16];
#pragma unroll
    for (int cc = 0; cc < 16; ++cc) o[cc] = (f32x4){0.f, 0.f, 0.f, 0.f};
    R_LOAD(0); R_WRITE(0, 0); R_LOAD(1); __syncthreads();
#pragma unroll
    for (int j = 0; j < 8; ++j) {
        const LAS unsigned char* tb = lds + (j & 1) * AT_BUF;
        if (j < 4) {
            if (j + 1 < 8) R_WRITE((j + 1) & 1, j + 1);
            if (j + 2 < 8) R_LOAD(j + 2);
#pragma unroll
            for (int cc = 0; cc < 16; ++cc) { const s16x4 lo = trr(tb + vra + cc * 32), hi = trr(tb + vra + 16 * AT_VS + cc * 32); o[cc] = MFMA16(qf[j & 3], BV8(lo, hi), o[cc]); }
            if (j == 3) {
                f32x4 xi;
#pragma unroll
                for (int r = 0; r < 4; ++r) xi[r] = fexp2((float)(16 * w + 4 * g + r + 1) * lg);
#pragma unroll
                for (int cc = 0; cc < 16; ++cc) o[cc] *= xi;
            }
        } else {
            const int i = j - 4;
            bf16x8 pa; bool live = (32 * i <= 16 * w + 15);
            if (live) {
                f32x4 s[2];
#pragma unroll
                for (int kb = 0; kb < 2; ++kb) { s[kb] = (f32x4){0.f, 0.f, 0.f, 0.f};
#pragma unroll
                    for (int sd = 0; sd < 4; ++sd) { const bf16x8 a = *(const LAS bf16x8*)(tb + kra + kb * 16 * AT_KS + sd * 64); s[kb] = MFMA16(a, qf[sd], s[kb]); } }
#pragma unroll
                for (int kb = 0; kb < 2; ++kb)
#pragma unroll
                    for (int r = 0; r < 4; ++r) { const int d = (16 * w + li) - (32 * i + 16 * kb + 4 * g + r); s[kb][r] = d >= 0 ? s[kb][r] * fexp2((float)d * lg) : 0.f; }
                u32x4 pw; pw.x = cvtpk(s[0][0], s[0][1]); pw.y = cvtpk(s[0][2], s[0][3]); pw.z = cvtpk(s[1][0], s[1][1]); pw.w = cvtpk(s[1][2], s[1][3]);
                pa = __builtin_bit_cast(bf16x8, pw);
            }
            if (j + 1 < 8) R_WRITE((j + 1) & 1, j + 1);
            if (j + 2 < 8) R_LOAD(j + 2);
            if (live) {
#pragma unroll
                for (int cc = 0; cc < 16; ++cc) { const s16x4 lo = trr(tb + vra + cc * 32), hi = trr(tb + vra + 16 * AT_VS + cc * 32); o[cc] = MFMA16(pa, BV8(lo, hi), o[cc]); }
            }
        }
        __syncthreads();
    }
#undef R_LOAD
#undef R_WRITE
    f32x4 ss = {0.f, 0.f, 0.f, 0.f};
#pragma unroll
    for (int cc = 0; cc < 16; ++cc) ss += o[cc] * o[cc];
#pragma unroll
    for (int r = 0; r < 4; ++r) { float v = ss[r]; v += __shfl_xor(v, 1); v += __shfl_xor(v, 2); v += __shfl_xor(v, 4); v += __shfl_xor(v, 8); ss[r] = 1.0f / sqrtf(v * (1.f / 256.f) + EPS); }
    const bf16* gp = Pb + (size_t)(16 * w + 4 * g) * NIN + C_RG + h * 256 + li;
    bf16* mx = (bf16*)(F.ws + WS_MIXED) + (size_t)(b * SEQ + 128 * (c - 1) + 16 * w + 4 * g) * DM + h * 256 + li;
#pragma unroll
    for (int cc = 0; cc < 16; ++cc)
#pragma unroll
        for (int r = 0; r < 4; ++r) { const float gt = __uint_as_float((unsigned)gp[(size_t)r * NIN + 16 * cc] << 16); mx[(size_t)r * DM + 16 * cc] = (bf16)f2bf(silu_f(gt) * o[cc][r] * ss[r]); }
}
__device__ __forceinline__ void router_task(Frame& F, int task) {
    const int lane = F.lane, g = lane >> 4, li = lane & 15, r0 = 16 * task;
    const float* h1 = F.out + (size_t)(r0 + li) * DM + 8 * g;
    const float* ss = (const float*)(F.ctl + CW_SS);
    const float rstd = 1.0f / sqrtf(__hip_atomic_load((const GAS float*)ss + r0 + li, RLX_AGENT) * (1.f / DM) + EPS);
    const float* g2 = F.in[10] + 8 * g;
    bf16* up = (bf16*)(F.ws + WS_U) + (size_t)(r0 + li) * DM + 8 * g;
    const bf16* whi = (const bf16*)(F.ws + WS_WR) + (size_t)li * DM + 8 * g; const bf16* wlo = whi + 80 * DM;
    f32x4 acc[5];
#pragma unroll
    for (int cb = 0; cb < 5; ++cb) acc[cb] = (f32x4){0.f, 0.f, 0.f, 0.f};
#pragma unroll 2
    for (int s = 0; s < 64; ++s) {
        const f32x4 x0 = *(const f32x4*)(h1 + 32 * s), x1 = *(const f32x4*)(h1 + 32 * s + 4), ga = *(const f32x4*)(g2 + 32 * s), gb = *(const f32x4*)(g2 + 32 * s + 4);
        const f32x4 v0 = x0 * rstd * ga, v1 = x1 * rstd * gb;
        u32x4 hw; hw.x = cvtpk(v0[0], v0[1]); hw.y = cvtpk(v0[2], v0[3]); hw.z = cvtpk(v1[0], v1[1]); hw.w = cvtpk(v1[2], v1[3]);
        u32x4 lw; lw.x = cvtpk(v0[0] - bf_lo(hw.x), v0[1] - bf_hi(hw.x)); lw.y = cvtpk(v0[2] - bf_lo(hw.y), v0[3] - bf_hi(hw.y));
        lw.z = cvtpk(v1[0] - bf_lo(hw.z), v1[1] - bf_hi(hw.z)); lw.w = cvtpk(v1[2] - bf_lo(hw.w), v1[3] - bf_hi(hw.w));
        *(u32x4*)(up + 32 * s) = hw;
        const bf16x8 ah = __builtin_bit_cast(bf16x8, hw), al = __builtin_bit_cast(bf16x8, lw);
#pragma unroll
        for (int cb = 0; cb < 5; ++cb) { const bf16x8 bh = *(const bf16x8*)(whi + (size_t)(16 * cb) * DM + 32 * s), bl = *(const bf16x8*)(wlo + (size_t)(16 * cb) * DM + 32 * s);
            acc[cb] = MFMA16(ah, bh, acc[cb]); acc[cb] = MFMA16(al, bh, acc[cb]); acc[cb] = MFMA16(ah, bl, acc[cb]); }
    }
    LAS float* lg = (LAS float*)(F.lds + F.wave * 5120);
#pragma unroll
    for (int cb = 0; cb < 5; ++cb)
#pragma unroll
        for (int r = 0; r < 4; ++r) lg[(4 * g + r) * 80 + 16 * cb + li] = acc[cb][r];
    LDS_WAIT();
    if (lane < 16) {
        const LAS float* row = lg + lane * 80;
        int gs = 0; float gm = row[64];
#pragma unroll
        for (int j = 1; j < 8; ++j) { const float v = row[64 + j]; if (v > gm) { gm = v; gs = j; } }
        float gsum = 0.f;
#pragma unroll
        for (int j = 0; j < 8; ++j) gsum += __expf(row[64 + j] - gm);
        const float ggate = 1.0f / gsum;
        const LAS float* er = row + 8 * gs;
        int i1 = 0; float e1 = er[0];
#pragma unroll
        for (int j = 1; j < 8; ++j) { const float v = er[j]; if (v > e1) { e1 = v; i1 = j; } }
        int i2 = -1; float e2 = -3.0e38f;
#pragma unroll
        for (int j = 0; j < 8; ++j) { const float v = er[j]; if (j != i1 && v > e2) { e2 = v; i2 = j; } }
        const float t = __expf(e2 - e1), pa = 1.0f / (1.0f + t), pb = t * pa;
        const int tok = r0 + lane, ea = 8 * gs + i1, eb = 8 * gs + i2;
        gu32* cnt = F.ctl + CW_CNT;
        const int ra = (int)__hip_atomic_fetch_add(cnt + ea, 1u, RLX_AGENT), rb = (int)__hip_atomic_fetch_add(cnt + eb, 1u, RLX_AGENT);
        int* list = (int*)(F.ws + WS_LIST); float* wl = (float*)(F.ws + WS_WL);
        list[(size_t)ea * NTOK + ra] = tok; wl[(size_t)ea * NTOK + ra] = ggate * pa;
        list[(size_t)eb * NTOK + rb] = tok; wl[(size_t)eb * NTOK + rb] = ggate * pb;
        ((int4*)(F.ws + WS_TOKSLOT))[tok] = make_int4(ea, ra, eb, rb);
    }
    LDS_WAIT();
}
__device__ __forceinline__ void moe_tables(Frame& F) {
    LAS int* tb = (LAS int*)(F.lds + MOE_TAB_OFF); LAS int* cn = tb + 128;
    if (F.tid < 64) cn[F.tid] = (int)__hip_atomic_load(F.ctl + CW_CNT + F.tid, RLX_AGENT);
    __syncthreads();
    if (F.tid == 0) { int a = 0; for (int e = 0; e < 64; ++e) { tb[e] = a; a += (cn[e] + 255) >> 8; } tb[64] = a; }
    __syncthreads();
}
template <bool WITH_Y> __device__ __forceinline__ void final_row(Frame& F, int tok, const LAS int* tb) {
    const int lane = F.lane;
    int4 ts = make_int4(0, 0, 0, 0); if (WITH_Y) ts = ((const int4*)(F.ws + WS_TOKSLOT))[tok];
    const bf16* Y = (const bf16*)(F.ws + WS_Y);
    const u32x2* ya = (const u32x2*)(Y + (size_t)(WITH_Y ? tb[ts.x] * 256 + ts.y : 0) * DM) + lane; const u32x2* yb = (const u32x2*)(Y + (size_t)(WITH_Y ? tb[ts.z] * 256 + ts.w : 0) * DM) + lane;
    f32x4* hr = (f32x4*)(F.out + (size_t)tok * DM) + lane;
    f32x4 v[8]; float s = 0.f;
#pragma unroll
    for (int j = 0; j < 8; ++j) { f32x4 h = hr[64 * j];
        if (WITH_Y) { const u32x2 a = ya[64 * j], b = yb[64 * j]; h[0] += bf_lo(a.x) + bf_lo(b.x); h[1] += bf_hi(a.x) + bf_hi(b.x); h[2] += bf_lo(a.y) + bf_lo(b.y); h[3] += bf_hi(a.y) + bf_hi(b.y); }
        v[j] = h; s += (h[0] * h[0] + h[1] * h[1]) + (h[2] * h[2] + h[3] * h[3]); }
    const float r = 1.0f / sqrtf(wave_sum(s) * (1.f / DM) + EPS);
    const f32x4* gf = (const f32x4*)F.in[16] + lane;
#pragma unroll
    for (int j = 0; j < 8; ++j) hr[64 * j] = v[j] * r * gf[64 * j];
}
#ifndef MK_N_LAUNCHES
#define MK_N_LAUNCHES 1
#endif
#ifndef MK_PHASE_MASK
#define MK_PHASE_MASK 0x3ff
#endif
#ifndef MK_BRINGUP
#define MK_BRINGUP 3
#endif
constexpr int N_PHASES = 10;
struct Args { const float* in[17]; float* out; unsigned char* ws; int ph_lo, ph_hi; };
__global__ void __launch_bounds__(NWAVES * 64, 2) mk_fwd(Args args) {
    extern __shared__ __attribute__((aligned(16))) unsigned char lds[];
    Frame F;
    F.lds = (LAS unsigned char*)lds;
    F.MISC = (volatile LAS unsigned*)(F.lds + MISC_OFF);
    F.tid = threadIdx.x; F.lane = F.tid & 63; F.wave = __builtin_amdgcn_readfirstlane(F.tid >> 6);
    F.G = gridDim.x; const int bx = blockIdx.x; const int vcu = (F.G % 8 == 0) ? (bx % 8) * (F.G / 8) + bx / 8 : bx;
    F.gw = bx * NWAVES + F.wave; F.ngw = F.G * NWAVES;
    F.ws = args.ws; F.ctl = (gu32*)(args.ws + WS_CTL); F.out = args.out;
#pragma unroll
    for (int i = 0; i < 17; ++i) F.in[i] = args.in[i];
    for (int u = F.tid; u < (LDS_BYTES - LDSCTL_OFF) / 4; u += NWAVES * 64) ((LAS unsigned*)(F.lds + LDSCTL_OFF))[u] = 0u;
    __syncthreads();
    XcdBarrier bar = xcd_barrier_post((unsigned*)(F.ctl + CW_BAR), F.MISC + 8);
    const int lo = args.ph_lo, hi = args.ph_hi;
#define IN(k) (lo <= (k) && (k) < hi && ((MK_PHASE_MASK >> (k)) & 1))
#define SEAM(k) do { if ((k) + 1 < hi) xcd_barrier(bar); } while (0)

    if (lo <= 0 && 0 < hi) { if ((MK_PHASE_MASK >> 0) & 1) p0_prologue(F); SEAM(0); }
    if (lo <= 1 && 1 < hi) { if ((MK_PHASE_MASK >> 1) & 1) {
        if (F.gw < 112) meta_proj_task(F, F.gw);
        pg8::Gemm g{(const bf16*)(F.ws + WS_U), (const bf16*)(F.ws + WS_WIN), NTOK, NIN, DM}; pg8::StaticOrder S; S.init(NTOK, NIN, F.G, bx);
        EpiProj E{(bf16*)(F.ws + WS_P), (const f32x2*)(F.ws + WS_TAB_RET), (const f32x2*)(F.ws + WS_TAB_DIFF)};
        pg8::gemm_phase<EpiProj, pg8::StaticOrder, false>(F.lds, g, S, E); }
        SEAM(1); }
    if (lo <= 2 && 2 < hi) { if ((MK_PHASE_MASK >> 2) & 1) { for (int u = vcu; u < 512; u += F.G) ret_kv_unit(F, u >> 7, (u >> 5) & 3, u & 31); }
        SEAM(2); }
    if (lo <= 3 && 3 < hi) { if ((MK_PHASE_MASK >> 3) & 1) ret_scan(F);
        SEAM(3); }
    if (lo <= 4 && 4 < hi) { if ((MK_PHASE_MASK >> 4) & 1) {
        for (int p = vcu; p < 256; p += F.G) { const int bh = p >> 4, s = p & 15; diff_unit(F, bh >> 2, bh & 3, 31 - s); diff_unit(F, bh >> 2, bh & 3, s); }
        if (MK_BRINGUP >= 2) { for (int u = vcu; u < 512; u += F.G) ret_out_unit(F, u >> 7, (u >> 5) & 3, (u & 31) + 1); }
        else { u32x4* m4 = (u32x4*)(F.ws + WS_MIXED); for (int e = F.gw * 64 + F.lane; e < NTOK * 128; e += F.ngw * 64) m4[(size_t)(e >> 7) * 256 + (e & 127)] = (u32x4){0u, 0u, 0u, 0u}; } }
        SEAM(4); }
    if (lo <= 5 && 5 < hi) { if ((MK_PHASE_MASK >> 5) & 1) {
        pg8::Gemm g{(const bf16*)(F.ws + WS_MIXED), (const bf16*)(F.ws + WS_WOUT), NTOK, DM, DM}; pg8::StaticOrder S; S.init(NTOK, DM, F.G, bx);
        EpiH1 E{F.in[0], F.out, (float*)(F.ctl + CW_SS)};
        pg8::gemm_phase<EpiH1, pg8::StaticOrder, false>(F.lds, g, S, E); }
        SEAM(5); }
    if (lo <= 6 && 6 < hi) { if ((MK_PHASE_MASK >> 6) & 1) { for (int t = F.wave * F.G + bx; t < NTOK / 16; t += F.ngw) router_task(F, t); }
        SEAM(6); }
    if (lo <= 7 && 7 < hi) { if ((MK_PHASE_MASK >> 7) & 1) {
        moe_tables(F);
        const LAS int* tb = (const LAS int*)(F.lds + MOE_TAB_OFF); const LAS int* cn = tb + 128; LAS unsigned* rowtab = (LAS unsigned*)(F.lds + MOE_ROWTAB_OFF);
        MoeSched S{tb, cn, rowtab, 4, F.G, bx};
        { pg8::Unit u; const int* list = (const int*)(F.ws + WS_LIST);
          for (int i = 0; i < 8 && S.next(i, u); ++i) if (F.tid < 256) { const int e = u.pn >> 2, r = (u.pm - tb[e]) * 256 + F.tid;
              const int tok = list[(size_t)e * NTOK + (r < cn[e] ? r : 0)]; rowtab[i * 256 + F.tid] = (unsigned)tok * (unsigned)(DM * 2); }
          __syncthreads(); }
        pg8::Gemm g{(const bf16*)(F.ws + WS_U), (const bf16*)(F.ws + WS_WGU), MAXSLOT, NEXP * 1024, DM};
        EpiAct E{(bf16*)(F.ws + WS_HACT)};
        pg8::gemm_phase<EpiAct, MoeSched, true>(F.lds, g, S, E); }
        SEAM(7); }
    if (lo <= 8 && 8 < hi) { if ((MK_PHASE_MASK >> 8) & 1) {
        moe_tables(F);
        const LAS int* tb = (const LAS int*)(F.lds + MOE_TAB_OFF); const LAS int* cn = tb + 128;
        MoeSched S{tb, cn, nullptr, 8, F.G, bx};
        pg8::Gemm g{(const bf16*)(F.ws + WS_HACT), (const bf16*)(F.ws + WS_WD), MAXSLOT, NEXP * DM, FF};
        EpiY E{(bf16*)(F.ws + WS_Y), (const float*)(F.ws + WS_WL), tb, cn};
        pg8::gemm_phase<EpiY, MoeSched, false>(F.lds, g, S, E); }
        SEAM(8); }
    if (lo <= 9 && 9 < hi) { if ((MK_PHASE_MASK >> 9) & 1) {
        moe_tables(F);
        const LAS int* tb = (const LAS int*)(F.lds + MOE_TAB_OFF);
        for (int t = F.gw; t < NTOK; t += F.ngw) final_row<(MK_BRINGUP >= 3)>(F, t, tb); } }
#undef IN
#undef SEAM
}

extern "C" void kernel_launch(void* const* d_in, const int* in_sizes, int n_in, void* d_out, int out_size, void* d_ws, size_t ws_size, hipStream_t stream) {
    static int grid = 0;
    if (grid == 0) {
        if (n_in != 17 || out_size != NTOK * DM || ws_size < WS_END) { fprintf(stderr, "kernel_launch: unexpected shapes (n_in %d out %d ws %zu, need ws >= %zu); nothing launched\n", n_in, out_size, ws_size, (size_t)WS_END); grid = -1; return; }
        int dev = 0, cus = 0, per_cu = 0;
        if (hipGetDevice(&dev) != hipSuccess || hipDeviceGetAttribute(&cus, hipDeviceAttributeMultiprocessorCount, dev) != hipSuccess) { grid = -1; return; }
        if (hipFuncSetAttribute((const void*)mk_fwd, hipFuncAttributeMaxDynamicSharedMemorySize, LDS_BYTES) != hipSuccess) { fprintf(stderr, "kernel_launch: hipFuncSetAttribute failed\n"); grid = -1; return; }
        if (hipOccupancyMaxActiveBlocksPerMultiprocessor(&per_cu, (const void*)mk_fwd, NWAVES * 64, LDS_BYTES) != hipSuccess || per_cu < 1) fprintf(stderr, "kernel_launch: occupancy query reports %d blocks per CU\n", per_cu);
        (void)hipGetLastError();
        grid = cus;
    }
    if (grid < 0) return;
    if (hipMemsetAsync((char*)d_ws + WS_CTL, 0, CTL_ZERO_BYTES, stream) != hipSuccess) return;
    Args a{};
    for (int i = 0; i < 17; ++i) a.in[i] = (const float*)d_in[i];
    a.out = (float*)d_out; a.ws = (unsigned char*)d_ws;
    if (MK_N_LAUNCHES == 1) { a.ph_lo = 0; a.ph_hi = N_PHASES; hipLaunchKernelGGL(mk_fwd, dim3(grid), dim3(NWAVES * 64), LDS_BYTES, stream, a); }
    else for (int p = 0; p < N_PHASES; ++p) { a.ph_lo = p; a.ph_hi = p + 1; hipLaunchKernelGGL(mk_fwd, dim3(grid), dim3(NWAVES * 64), LDS_BYTES, stream, a); }
}
```

```cpp
#include <hip/hip_runtime.h>
#include <cstdio>
#include <cstdint>
#include <cmath>
namespace pg8 {
#define PG8_LAS __attribute__((address_space(3)))
typedef unsigned short bf16_t;
typedef short bf16x8 __attribute__((ext_vector_type(8)));
typedef float f32x4 __attribute__((ext_vector_type(4)));
typedef unsigned u32x4 __attribute__((ext_vector_type(4)));
constexpr int BM = 256, BK = 64, HALF = 128, HTB = HALF * BK * 2  , STAGE_BYTES = 8 * HTB, NXCD = 8, WGM = 8;

__host__ __device__ __forceinline__ int lds_byte(int r, int c) { const int st = (r >> 4) * 2 + (c >> 5), rr = r & 15, cc = c & 31, ob = rr * 64 + cc * 2; return st * 1024 + (ob ^ (((ob >> 9) & 1) << 5)); }
__host__ __device__ __forceinline__ void stage_rc(int b, int& R, int& C) { const int st = b / 1024, sb = b % 1024, swz = sb ^ (((sb >> 9) & 1) << 5); R = (st >> 1) * 16 + swz / 64; C = (st & 1) * 32 + (swz % 64) / 2; }
__host__ __device__ __forceinline__ int perm32(int rho) { const int n = rho >> 4, i = rho & 15; return 8 * (i >> 2) + 4 * n + (i & 3); }

struct Unit { int pm, pn, aux; };
struct Gemm { const bf16_t* A; const bf16_t* Bt; int M, N, K; };

struct StaticOrder {
    int nM, nN, nwg, G, c;
    __host__ __device__ void init(int M, int N, int G_, int c_) { nM = M / BM; nN = N / BM; nwg = nM * nN; G = G_; c = c_; }
    __host__ __device__ bool next(int i, Unit& u) const {
        const long L = (long)i * G + c; if (L >= nwg) return false;
        int wgid = (int)L; { const int q = nwg / NXCD, r = nwg % NXCD, xcd = wgid % NXCD, off = wgid / NXCD; wgid = (xcd < r ? xcd * (q + 1) : r * (q + 1) + (xcd - r) * q) + off; }
        const int nig = WGM * nN, gid = wgid / nig, fm = gid * WGM, gsz = (nM - fm) < WGM ? (nM - fm) : WGM;
        u.pm = fm + ((wgid % nig) % gsz); u.pn = (wgid % nig) / gsz; return true;
    }
    __device__ __forceinline__ unsigned rowoff(const Unit&, int) const { return 0u; }
};

__device__ __forceinline__ unsigned cvt_pk_bf16(float lo, float hi) { unsigned r; asm volatile("v_cvt_pk_bf16_f32 %0, %1, %2" : "=v"(r) : "v"(lo), "v"(hi)); return r; }

template <class Epi, class Sched, bool GATHER, bool HALFSKIP = false>
__device__ __forceinline__ void gemm_phase(PG8_LAS unsigned char* lds, const Gemm g, const Sched& S, const Epi& E) {
    const int tid = threadIdx.x, wid = __builtin_amdgcn_readfirstlane(tid >> 6), lane = tid & 63, wr = wid >> 2, wc = wid & 3, fr = lane & 15, fq = lane >> 4;
    const int K = g.K, nt = K / BK;
    unsigned voffA[2], voffB[2]; int RA[2], CA[2];
#pragma unroll
    for (int i = 0; i < 2; ++i) { int R, C; stage_rc(tid * 16 + i * 8192, R, C); const int Rb = Epi::PERM ? ((R & ~31) + perm32(R & 31)) : R;
        RA[i] = R; CA[i] = C; voffA[i] = (unsigned)(R * K + C) * 2u; voffB[i] = (unsigned)(Rb * K + C) * 2u; }
    const size_t kstep = (size_t)(BK * 2);
    const size_t hstep = (size_t)HALF * K * 2;
    const size_t tstep = 2 * hstep;
    const unsigned ldsw = (unsigned)wid * 1024u;
    const int aoff = lds_byte(wr * 64 + fr, fq * 8), boff = lds_byte(wc * 32 + fr, fq * 8);
#define PG8_SA(b, h) (((b) * 2 + (h)) * HTB)
#define PG8_SB(b, h) ((4 + (b) * 2 + (h)) * HTB)
#define PG8_STAGE(bufoff, gbase, voff) do { _Pragma("unroll") for (int _i = 0; _i < 2; ++_i) \
        __builtin_amdgcn_global_load_lds((const unsigned*)((const char*)(gbase) + (voff)[_i]), (PG8_LAS unsigned*)(lds + (bufoff) + ldsw + _i * 8192), 16, 0, 0); } while (0)
#define PG8_STAGE_A(bufoff, gb, h, nx) do { if constexpr (GATHER) { _Pragma("unroll") for (int _i = 0; _i < 2; ++_i) \
        __builtin_amdgcn_global_load_lds((const unsigned*)((const char*)(gb) + ((nx) ? vGn[h][_i] : vGc[h][_i])), (PG8_LAS unsigned*)(lds + (bufoff) + ldsw + _i * 8192), 16, 0, 0); } \
        else { PG8_STAGE(bufoff, (gb) + (h) * hstep, voffA); } } while (0)
#define PG8_LDA(dst, b, h) do { _Pragma("unroll") for (int m = 0; m < 4; ++m) _Pragma("unroll") for (int k = 0; k < 2; ++k) dst[m][k] = *(const PG8_LAS bf16x8*)(lds + PG8_SA(b, h) + aoff + m * 2048 + k * 1024); } while (0)
#define PG8_LDB(dst, b, h) do { _Pragma("unroll") for (int n = 0; n < 2; ++n) _Pragma("unroll") for (int k = 0; k < 2; ++k) dst[n][k] = *(const PG8_LAS bf16x8*)(lds + PG8_SB(b, h) + boff + n * 2048 + k * 1024); } while (0)
#define PG8_MMA(ai, bj, At, Bt) do { __builtin_amdgcn_s_setprio(1); _Pragma("unroll") for (int m = 0; m < 4; ++m) _Pragma("unroll") for (int n = 0; n < 2; ++n) _Pragma("unroll") for (int k = 0; k < 2; ++k) \
        acc[ai][bj][m][n] = __builtin_amdgcn_mfma_f32_16x16x32_bf16(Bt[n][k], At[m][k], acc[ai][bj][m][n], 0, 0, 0); __builtin_amdgcn_s_setprio(0); } while (0)
#define PG8_WAIT_V(n) asm volatile("s_waitcnt vmcnt(" #n ")" ::: "memory")
#define PG8_WAIT_L(n) asm volatile("s_waitcnt lgkmcnt(" #n ")" ::: "memory")
#define PG8_BAR __builtin_amdgcn_s_barrier()
#define PG8_SCHED __builtin_amdgcn_sched_barrier(0)
    Unit cur, nxt; int ui = 0;
    if (!S.next(0, cur)) return;
    f32x4 acc[2][2][4][2];
#pragma unroll
    for (int a = 0; a < 2; ++a)
#pragma unroll
        for (int b = 0; b < 2; ++b)
#pragma unroll
            for (int m = 0; m < 4; ++m)
#pragma unroll
                for (int n = 0; n < 2; ++n) acc[a][b][m][n] = (f32x4){0.f, 0.f, 0.f, 0.f};
    bf16x8 At[4][2], B0[2][2], B1[2][2];
    unsigned vGc[2][2] = {{0u, 0u}, {0u, 0u}}, vGn[2][2] = {{0u, 0u}, {0u, 0u}};
    if constexpr (GATHER) {
#pragma unroll
        for (int h = 0; h < 2; ++h)
#pragma unroll
            for (int i = 0; i < 2; ++i) { vGc[h][i] = S.rowoff(cur, h * HALF + RA[i]) + (unsigned)CA[i] * 2u; vGn[h][i] = vGc[h][i]; }
    }
    const char* cA = GATHER ? (const char*)g.A : (const char*)g.A + (size_t)cur.pm * tstep; const char* cB = (const char*)g.Bt + (size_t)cur.pn * tstep;
    PG8_STAGE(PG8_SB(0, 0), cB, voffB); PG8_STAGE(PG8_SB(0, 1), cB + hstep, voffB); PG8_STAGE_A(PG8_SA(0, 0), cA, 0, false); PG8_STAGE_A(PG8_SA(0, 1), cA, 1, false);
    if (wr == 1) PG8_BAR;
    PG8_WAIT_V(2); PG8_BAR;
    PG8_STAGE(PG8_SB(1, 0), cB + kstep, voffB); PG8_STAGE_A(PG8_SA(1, 0), cA + kstep, 0, false); PG8_STAGE(PG8_SB(1, 1), cB + hstep + kstep, voffB);
    PG8_WAIT_V(6); PG8_BAR;
    for (;;) {
        const bool has_next = S.next(ui + 1, nxt);
        const bool chalf = HALFSKIP && ((cur.aux >> 16) & 1);
        if constexpr (GATHER) { if (has_next) {
#pragma unroll
            for (int h = 0; h < 2; ++h)
#pragma unroll
                for (int i = 0; i < 2; ++i) vGn[h][i] = S.rowoff(nxt, h * HALF + RA[i]) + (unsigned)CA[i] * 2u; } }
        const char* nA = GATHER ? cA : (has_next ? (const char*)g.A + (size_t)nxt.pm * tstep : cA); const char* nB = has_next ? (const char*)g.Bt + (size_t)nxt.pn * tstep : cB;
        for (int t = 0; t < nt; t += 2) {
            const bool last = (t == nt - 2);
            const char* a1 = cA + (size_t)(t + 1) * kstep;
            const char* a2 = last ? nA : cA + (size_t)(t + 2) * kstep; const char* b2 = last ? nB : cB + (size_t)(t + 2) * kstep;
            const char* a3 = a2 + kstep; const char* b3 = b2 + kstep;
            PG8_LDB(B0, 0, 0); PG8_LDB(B1, 0, 1); PG8_SCHED; PG8_LDA(At, 0, 0); PG8_STAGE_A(PG8_SA(1, 1), a1, 1, false);
            PG8_WAIT_V(8); PG8_WAIT_L(0); PG8_BAR; PG8_MMA(0, 0, At, B0); PG8_MMA(0, 1, At, B1); PG8_BAR; PG8_SCHED;
            PG8_LDA(At, 0, 1); PG8_STAGE(PG8_SB(0, 0), b2, voffB); PG8_STAGE(PG8_SB(0, 1), b2 + hstep, voffB); PG8_STAGE_A(PG8_SA(0, 0), a2, 0, last);
            PG8_WAIT_V(8); PG8_WAIT_L(0); PG8_BAR; if (!HALFSKIP || !chalf) { PG8_MMA(1, 0, At, B0); PG8_MMA(1, 1, At, B1); } PG8_BAR; PG8_SCHED;
            PG8_LDB(B0, 1, 0); PG8_LDB(B1, 1, 1); PG8_SCHED; PG8_LDA(At, 1, 0); PG8_STAGE_A(PG8_SA(0, 1), a2, 1, last);
            PG8_WAIT_V(8); PG8_WAIT_L(0); PG8_BAR; PG8_MMA(0, 0, At, B0); PG8_MMA(0, 1, At, B1); PG8_BAR; PG8_SCHED;
            PG8_LDA(At, 1, 1); PG8_STAGE(PG8_SB(1, 0), b3, voffB); PG8_STAGE(PG8_SB(1, 1), b3 + hstep, voffB); PG8_STAGE_A(PG8_SA(1, 0), a3, 0, last);
            PG8_WAIT_V(8); PG8_WAIT_L(0); PG8_BAR; if (!HALFSKIP || !chalf) { PG8_MMA(1, 0, At, B0); PG8_MMA(1, 1, At, B1); } PG8_BAR; PG8_SCHED;
        }
        if (wr == 0) PG8_BAR;
        E(acc, cur, wr, wc, fr, fq);
        if (!has_next) break;
#pragma unroll
        for (int a = 0; a < 2; ++a)
#pragma unroll
            for (int b = 0; b < 2; ++b)
#pragma unroll
                for (int m = 0; m < 4; ++m)
#pragma unroll
                    for (int n = 0; n < 2; ++n) acc[a][b][m][n] = (f32x4){0.f, 0.f, 0.f, 0.f};
        cur = nxt; cA = nA; cB = nB; ++ui;
        if constexpr (GATHER) {
#pragma unroll
            for (int h = 0; h < 2; ++h)
#pragma unroll
                for (int i = 0; i < 2; ++i) vGc[h][i] = vGn[h][i]; }
        if (wr == 1) PG8_BAR;
    }
    PG8_WAIT_V(0);
    PG8_BAR;
#undef PG8_SA
#undef PG8_SB
#undef PG8_STAGE
#undef PG8_STAGE_A
#undef PG8_LDA
#undef PG8_LDB
#undef PG8_MMA
#undef PG8_WAIT_V
#undef PG8_WAIT_L
#undef PG8_BAR
#undef PG8_SCHED
}
}
#define GAS __attribute__((address_space(1)))
#define LAS __attribute__((address_space(3)))
typedef unsigned short bf16;
typedef unsigned v4u __attribute__((ext_vector_type(4)));
typedef float f32x4 __attribute__((ext_vector_type(4)));
typedef short bf16x8 __attribute__((ext_vector_type(8)));
typedef GAS unsigned gu32;
typedef GAS unsigned long long gu64;
#define RLX_AGENT __ATOMIC_RELAXED, __HIP_MEMORY_SCOPE_AGENT
#define LDS_WAIT() asm volatile("s_waitcnt lgkmcnt(0)" ::: "memory")
#define VM_WAIT() asm volatile("s_waitcnt vmcnt(0)" ::: "memory")
__device__ __forceinline__ unsigned long long rt() { return __builtin_amdgcn_s_memrealtime(); }
__device__ __forceinline__ unsigned f2bf(float f) { unsigned u = __builtin_bit_cast(unsigned, f); return (u + 0x7fffu + ((u >> 16) & 1u)) >> 16; }
__device__ __forceinline__ unsigned pk2(float lo, float hi) { return f2bf(lo) | (f2bf(hi) << 16); }
#define XB_TMO      128
#define XB_XCNT(j)  (256  + 64 * (j))
#define XB_XSUB(j)  (1280 + 64 * (j))
#define XB_XGEN(j)  (2304 + 64 * (j))
#define XB_TOP      3328
#define XB_TOPGEN   3392
#define XCD_BAR_WORDS 3456
#define XB_SPIN_CAP (1u << 18)

__device__ __forceinline__ unsigned xb_ld(unsigned* p)              { return __hip_atomic_load(p, __ATOMIC_RELAXED, __HIP_MEMORY_SCOPE_AGENT); }
__device__ __forceinline__ unsigned xb_add(unsigned* p, unsigned v) { return __hip_atomic_fetch_add(p, v, __ATOMIC_RELAXED, __HIP_MEMORY_SCOPE_AGENT); }
__device__ __forceinline__ unsigned xb_xcc_id() { return (unsigned)__builtin_amdgcn_s_getreg((3 << 11) | 20) & 0xFu; }
#define XB_SPIN(cond, bar) do { unsigned _sp = 0; while (cond) { __builtin_amdgcn_s_sleep(1); \
    if ((++_sp & 255u) == 0u) { if (xb_ld(&(bar)[XB_TMO])) break; if (_sp > XB_SPIN_CAP) { atomicAdd(&(bar)[XB_TMO], 1u); break; } } } } while (0)

struct XcdBarrier {
    unsigned* bar; unsigned x;
    volatile LAS unsigned* st;
};

__device__ __forceinline__ XcdBarrier xcd_barrier_post(unsigned* bar, volatile LAS unsigned* st) {
    XcdBarrier b; b.bar = bar; b.x = xb_xcc_id(); b.st = st;
    if (threadIdx.x == 0) (void)xb_add(&bar[XB_XCNT(b.x)], 1u);
    return b;
}
__device__ __forceinline__ void xcd_barrier_complete(unsigned* bar, unsigned x, unsigned& nloc, unsigned& nx) {
    const unsigned G = gridDim.x * gridDim.y * gridDim.z;
    unsigned sum, cnt, mine, sp = 0u;
    for (;;) {
        sum = 0u; cnt = 0u; mine = 0u;
#pragma unroll
        for (unsigned j = 0; j < 16; ++j) { const unsigned c = xb_ld(&bar[XB_XCNT(j)]); sum += c; cnt += (c > 0u) ? 1u : 0u; mine = (j == x) ? c : mine; }
        if (sum == G) break;
        __builtin_amdgcn_s_sleep(1);
        if ((++sp & 255u) == 0u) { if (xb_ld(&bar[XB_TMO])) break; if (sp > XB_SPIN_CAP) { atomicAdd(&bar[XB_TMO], 1u); break; } }
    }
    nloc = mine > 0u ? mine : 1u; nx = cnt > 0u ? cnt : 1u;
}

__device__ __forceinline__ void xcd_barrier(const XcdBarrier& b) {
    asm volatile("s_waitcnt vmcnt(0)" ::: "memory");
    __syncthreads();
    if (threadIdx.x == 0) {
        unsigned* bar = b.bar;
        __builtin_amdgcn_s_waitcnt(0);
        unsigned nloc = b.st[0], nx = b.st[1];
        if (nloc == 0u) { xcd_barrier_complete(bar, b.x, nloc, nx); b.st[0] = nloc; b.st[1] = nx; }
        const unsigned old = xb_add(&bar[XB_XSUB(b.x)], 1u);
        const unsigned gen = old / nloc;
        if (old + 1u == (gen + 1u) * nloc) {
            __builtin_amdgcn_fence(__ATOMIC_RELEASE, "agent");
            asm volatile("s_waitcnt vmcnt(0)" ::: "memory");
            const unsigned og = xb_add(&bar[XB_TOP], 1u);
            const unsigned tg = og / nx;
            if (og + 1u == (tg + 1u) * nx) xb_add(&bar[XB_TOPGEN], 1u);
            else XB_SPIN(xb_ld(&bar[XB_TOPGEN]) == tg, bar);
            __builtin_amdgcn_fence(__ATOMIC_ACQUIRE, "agent");
            xb_add(&bar[XB_XGEN(b.x)], 1u);
            asm volatile("s_waitcnt vmcnt(0)" ::: "memory");
        } else {
            XB_SPIN(xb_ld(&bar[XB_XGEN(b.x)]) == gen, bar);
            __builtin_amdgcn_fence(__ATOMIC_ACQUIRE, "agent");
            asm volatile("s_waitcnt vmcnt(0)" ::: "memory");
        }
    }
    __syncthreads();
}
#ifndef MK_LATE_WD
#define MK_LATE_WD 0
#endif
#ifndef MK_W1
#define MK_W1 36
#define MK_W2 34
#endif
#ifndef MK_GU_FIRST_PCT
#define MK_GU_FIRST_PCT 60
#endif
#ifndef MK_GU_IN_P4
#define MK_GU_IN_P4 1
#endif
constexpr int NWAVES = 8;
constexpr int DM = 2048, NB = 4, SEQ = 4096, NTOK = NB * SEQ;
constexpr int LPAD = 4224, LROWS = NB * LPAD;
constexpr int NIN = 6144;
constexpr int C_RQ = 0, C_RK = 512, C_RV = 1024, C_RG = 2048, C_DQ = 3072, C_DK = 4096, C_DV = 5120;
constexpr int NEXP = 64, FF = 512, NPOS = 4112;
constexpr float EPS = 1e-6f;
constexpr float QK_SCALE = 0.08838834764831845f;
constexpr float LOG2E = 1.4426950408889634f;
constexpr float LAMBDA_INIT = 0.2f;
constexpr int MAXSLOT = 49152;

constexpr size_t MiB = 1u << 20;
constexpr size_t WS_CTL = 0, CTL_ZERO_BYTES = 1 * MiB;
constexpr size_t WS_TAB_RET = 1 * MiB;
constexpr size_t WS_TAB_DIFF = 4 * MiB;
constexpr size_t WS_MISC = 5 * MiB;
constexpr size_t WS_WR = 6 * MiB;
constexpr size_t WS_LIST = 8 * MiB, WS_WL = 12 * MiB, WS_TOKSLOT = 16 * MiB, WS_SSP = 17 * MiB;
constexpr size_t WS_WIN = 20 * MiB, WS_WOUT = 44 * MiB, WS_WGU = 52 * MiB, WS_WD = 308 * MiB;
constexpr size_t WS_U = 436 * MiB, WS_MIXED = 500 * MiB, WS_P = 564 * MiB, WS_KV = 762 * MiB, WS_S = 826 * MiB, WS_END = 858 * MiB;
constexpr size_t WS_Y = WS_P, WS_HACT = WS_KV;
static_assert(WS_P + (size_t)LROWS * NIN * 2 <= WS_KV && WS_Y + (size_t)MAXSLOT * DM * 2 <= WS_KV && WS_HACT + (size_t)MAXSLOT * FF * 2 <= WS_S, "ws map");
constexpr int CW_TMO = 0, CW_CODE = 1, CW_Q = 64  , CW_BAR = 4096, CW_CNT = 8192  , CW_SS = 16384  ;
static_assert((CW_SS + NTOK) * 4 <= (int)CTL_ZERO_BYTES, "ctl");

constexpr int RING_BYTES = 131072;
constexpr int MOE_TAB_OFF = RING_BYTES;
constexpr int MOE_ROWTAB_OFF = MOE_TAB_OFF + 2048;
constexpr int LDSCTL_OFF = MOE_ROWTAB_OFF + 7 * 1024, MISC_OFF = LDSCTL_OFF + 320;
constexpr int LDS_BYTES = 147456;
static_assert(MISC_OFF + 128 <= LDS_BYTES, "LDS map");

typedef unsigned u32x4 __attribute__((ext_vector_type(4)));
typedef unsigned u32x2 __attribute__((ext_vector_type(2)));
typedef float f32x2 __attribute__((ext_vector_type(2)));
typedef short s16x4 __attribute__((ext_vector_type(4)));

__device__ __forceinline__ unsigned cvtpk(float lo, float hi) { return pg8::cvt_pk_bf16(lo, hi); }
__device__ __forceinline__ float bf_lo(unsigned w) { return __uint_as_float(w << 16); }
__device__ __forceinline__ float bf_hi(unsigned w) { return __uint_as_float(w & 0xffff0000u); }
__device__ __forceinline__ float wave_sum(float v) {
#pragma unroll
    for (int o = 1; o < 64; o <<= 1) v += __shfl_xor(v, o);
    return v;
}
__device__ __forceinline__ float xmax16(float v) { auto r = __builtin_amdgcn_permlane16_swap(__float_as_uint(v), __float_as_uint(v), false, false); return fmaxf(__uint_as_float(r[0]), __uint_as_float(r[1])); }
__device__ __forceinline__ float xmax32(float v) { auto r = __builtin_amdgcn_permlane32_swap(__float_as_uint(v), __float_as_uint(v), false, false); return fmaxf(__uint_as_float(r[0]), __uint_as_float(r[1])); }
__device__ __forceinline__ float xsum16(float v) { auto r = __builtin_amdgcn_permlane16_swap(__float_as_uint(v), __float_as_uint(v), false, false); return __uint_as_float(r[0]) + __uint_as_float(r[1]); }
__device__ __forceinline__ float xsum32(float v) { auto r = __builtin_amdgcn_permlane32_swap(__float_as_uint(v), __float_as_uint(v), false, false); return __uint_as_float(r[0]) + __uint_as_float(r[1]); }

struct Frame {
    LAS unsigned char* lds;
    volatile LAS unsigned* MISC;
    gu32* ctl;
    int tid, lane, wave, G, gw, ngw;
    unsigned char* ws;
    const float* in[17];
    float* out;
    int dup;
};
__device__ __forceinline__ void sincos_d(double a, float& s, float& c) {
    const double k = __builtin_rint(a * 0.63661977236758134308);
    double r = __builtin_fma(-k, 1.57079632679489655800e+00, a);
    r = __builtin_fma(-k, 6.12323399573676603587e-17, r);
    const double r2 = r * r;
    double sp = 1.0 / 6227020800.0; sp = __builtin_fma(sp, r2, -1.0 / 39916800.0); sp = __builtin_fma(sp, r2, 1.0 / 362880.0); sp = __builtin_fma(sp, r2, -1.0 / 5040.0);
    sp = __builtin_fma(sp, r2, 1.0 / 120.0); sp = __builtin_fma(sp, r2, -1.0 / 6.0); sp = __builtin_fma(sp * r2, r, r);
    double cp = -1.0 / 87178291200.0; cp = __builtin_fma(cp, r2, 1.0 / 479001600.0); cp = __builtin_fma(cp, r2, -1.0 / 3628800.0); cp = __builtin_fma(cp, r2, 1.0 / 40320.0);
    cp = __builtin_fma(cp, r2, -1.0 / 720.0); cp = __builtin_fma(cp, r2, 1.0 / 24.0); cp = __builtin_fma(cp, r2, -0.5); cp = __builtin_fma(cp, r2, 1.0);
    const int q = ((int)k) & 3;
    const double sv = (q == 0) ? sp : (q == 1) ? cp : (q == 2) ? -sp : -cp;
    const double cv = (q == 0) ? cp : (q == 1) ? -sp : (q == 2) ? -cp : sp;
    s = (float)sv; c = (float)cv;
}
__host__ __device__ __forceinline__ int win_dest(int n) {
    if (n < 1024) { const int tile = n >> 8, head2 = (n >> 7) & 1, d = n & 127; return tile * 256 + (d < 64 ? head2 * 64 + d : 128 + head2 * 64 + (d - 64)); }
    if (n >= C_DQ && n < C_DV) { const int tile = n >> 8, comp = (n >> 7) & 1, d = n & 127;
        return tile * 256 + (d < 16 ? comp * 16 + d : d < 32 ? 128 + comp * 16 + (d - 16) : comp * 128 + d); }
    return n;
}
struct TrItem { const float* src; bf16* dst; int N, K, mode, n0; };
constexpr int TR_I_IN = 32 * 96, TR_I_OUT = 32 * 32, TR_I_G = 64 * 256, TR_I_D = 64 * 256, TR_ITEMS = TR_I_IN + TR_I_OUT + 2 * TR_I_G + TR_I_D;
__device__ __forceinline__ TrItem tr_desc(Frame& F, int it) {
    TrItem d; int r = it;
    if (r < TR_I_IN) { const int kb = r / 96, nb = r % 96; d.N = NIN; d.K = DM; d.mode = 1; d.n0 = nb * 64; d.src = F.in[3] + (size_t)(kb * 64) * NIN + nb * 64; d.dst = (bf16*)(F.ws + WS_WIN) + kb * 64; return d; } r -= TR_I_IN;
    if (r < TR_I_OUT) { const int kb = r >> 5, nb = r & 31; d.N = DM; d.K = DM; d.mode = 0; d.n0 = nb * 64; d.src = F.in[4] + (size_t)(kb * 64) * DM + nb * 64; d.dst = (bf16*)(F.ws + WS_WOUT) + kb * 64; return d; } r -= TR_I_OUT;
    if (r < 2 * TR_I_G) { const int up = r >= TR_I_G; if (up) r -= TR_I_G; const int e = r >> 8, q = r & 255, kb = q >> 3, nb = q & 7; d.N = FF; d.K = DM; d.mode = 2 + up; d.n0 = nb * 64;
        d.src = F.in[13 + up] + (size_t)e * DM * FF + (size_t)(kb * 64) * FF + nb * 64; d.dst = (bf16*)(F.ws + WS_WGU) + (size_t)e * 1024 * DM + kb * 64; return d; } r -= 2 * TR_I_G;
    { const int e = r >> 8, q = r & 255, kb = q >> 5, nb = q & 31; d.N = DM; d.K = FF; d.mode = 0; d.n0 = nb * 64; d.src = F.in[15] + (size_t)e * FF * DM + (size_t)(kb * 64) * DM + nb * 64; d.dst = (bf16*)(F.ws + WS_WD) + (size_t)e * DM * FF + kb * 64; return d; }
}
__device__ __forceinline__ int tr_dest(int mode, int n) { return mode == 0 ? n : mode == 1 ? win_dest(n) : mode == 2 ? ((n >> 7) * 256 + (n & 127)) : ((n >> 7) * 256 + 128 + (n & 127)); }
#define TR_ISSUE(v, d) do { const float* s_ = (d).src + (size_t)(lane >> 4) * (d).N + 4 * (lane & 15); _Pragma("unroll") for (int i_ = 0; i_ < 16; ++i_) v[i_] = __builtin_nontemporal_load((const f32x4*)(s_ + (size_t)(4 * i_) * (d).N)); } while (0)
#define TR_PROCESS(v, d) do { \
        _Pragma("unroll") for (int i_ = 0; i_ < 16; ++i_) { LAS float* w_ = scr + (4 * i_ + (lane >> 4)) * 65 + 4 * (lane & 15); w_[0] = v[i_][0]; w_[1] = v[i_][1]; w_[2] = v[i_][2]; w_[3] = v[i_][3]; } \
        LDS_WAIT(); \
        _Pragma("unroll") for (int p_ = 0; p_ < 8; ++p_) { const int n_ = 8 * p_ + (lane >> 3); const LAS float* r_ = scr + (8 * (lane & 7)) * 65 + n_; \
            u32x4 o_; o_.x = cvtpk(r_[0], r_[65]); o_.y = cvtpk(r_[130], r_[195]); o_.z = cvtpk(r_[260], r_[325]); o_.w = cvtpk(r_[390], r_[455]); \
            __builtin_nontemporal_store(o_, (u32x4*)((d).dst + (size_t)tr_dest((d).mode, (d).n0 + n_) * (d).K + 8 * (lane & 7))); } \
        LDS_WAIT(); } while (0)
__device__ __forceinline__ void p0_weights(Frame& F, int first, int last, int wr, int nw) {
    int lane = F.lane; asm volatile("" : "+v"(lane));
    int wofs = F.wave * 16640; asm volatile("" : "+s"(wofs));
    LAS float* scr = (LAS float*)(F.lds + wofs);
    f32x4 va[16], vb[16];
    int it = first + wr; if (it >= last) return;
    TrItem da = tr_desc(F, it), db = da; TR_ISSUE(va, da);
    for (;;) {
        const int itb = it + nw; const bool hb = itb < last; if (hb) { db = tr_desc(F, itb); TR_ISSUE(vb, db); }
        TR_PROCESS(va, da);
        if (!hb) break;
        it = itb + nw; const bool ha = it < last; if (ha) { da = tr_desc(F, it); TR_ISSUE(va, da); }
        TR_PROCESS(vb, db);
        if (!ha) break;
    }
}
__device__ __forceinline__ void rms_row_to_bf16(const float* __restrict__ xrow, const float* __restrict__ g, bf16* __restrict__ orow, int lane) {
    const f32x4* xr = (const f32x4*)xrow + lane; f32x4 v[8]; float s = 0.f;
#pragma unroll
    for (int j = 0; j < 8; ++j) { v[j] = xr[64 * j]; s += (v[j].x * v[j].x + v[j].y * v[j].y) + (v[j].z * v[j].z + v[j].w * v[j].w); }
    const float r = 1.0f / sqrtf(wave_sum(s) * (1.f / DM) + EPS);
    u32x2* o8 = (u32x2*)orow + lane;
#pragma unroll
    for (int j = 0; j < 8; ++j) { const f32x4 gg = ((const f32x4*)g)[lane + 64 * j]; u32x2 w; w.x = cvtpk(v[j].x * r * gg.x, v[j].y * r * gg.y); w.y = cvtpk(v[j].z * r * gg.z, v[j].w * r * gg.w); o8[64 * j] = w; }
}
__device__ __forceinline__ void p0_prologue(Frame& F) {
    unsigned char* ws = F.ws;
    const int gt = F.gw * 64 + F.lane, ngt = F.ngw * 64;
    { f32x2* tr = (f32x2*)(ws + WS_TAB_RET); f32x2* td = (f32x2*)(ws + WS_TAB_DIFF);
      for (int e = gt; e < NPOS * 80; e += ngt) { const int pos = e / 80, i = e - pos * 80;
        float inv; if (i < 64) inv = 1.0f / __builtin_amdgcn_exp2f((float)i * (13.287712379549449f / 63.0f)); else inv = __builtin_amdgcn_exp2f(-(float)(i - 64) * (18.931568569324174f / 16.0f));
        const float ang = (float)pos * inv; float s, c; sincos_d((double)ang, s, c);
        if (i < 64) tr[pos * 64 + i] = (f32x2){c, s}; else td[pos * 16 + (i - 64)] = (f32x2){c, s}; } }
    if (gt == 0) { float a = 0.f, b = 0.f; for (int i = 0; i < 128; ++i) { a += F.in[5][i] * F.in[6][i]; b += F.in[7][i] * F.in[8][i]; }
        *(float*)(ws + WS_MISC) = expf(a) - expf(b) + LAMBDA_INIT; }
    { bf16* wr = (bf16*)(ws + WS_WR);
      for (int e = gt; e < 80 * DM; e += ngt) { const int n = e >> 11, k = e & 2047; const float v = n < 64 ? F.in[12][(size_t)k * 64 + n] : n < 72 ? F.in[11][(size_t)k * 8 + (n - 64)] : 0.f;
        const unsigned h = f2bf(v); const float hv = __uint_as_float(h << 16); wr[e] = (bf16)h; wr[80 * DM + e] = (bf16)f2bf(v - hv); } }
    { u32x4* P4 = (u32x4*)(ws + WS_P);
      for (int e = gt; e < NB * 112 * 768; e += ngt) { const int r = e / 768, ch = e - r * 768, b = r / 112, l = r - b * 112; P4[(size_t)(b * LPAD + l) * 768 + ch] = (u32x4){0u, 0u, 0u, 0u}; } }
    for (int m = F.gw; m < 16; m += F.ngw) rms_row_to_bf16(F.in[1] + (size_t)m * DM, F.in[2], (bf16*)(ws + WS_MISC + 4096) + (size_t)m * DM, F.lane);
    for (int m = F.gw; m < NTOK; m += F.ngw) rms_row_to_bf16(F.in[0] + (size_t)m * DM, F.in[2], (bf16*)(ws + WS_U) + (size_t)m * DM, F.lane);
    p0_weights(F, 0, MK_GU_IN_P4 ? TR_I_IN + TR_I_OUT : MK_LATE_WD ? TR_ITEMS - TR_I_D : TR_ITEMS, F.gw, F.ngw);
}
__host__ __device__ __forceinline__ int tile_type(int pn) { return pn < 2 ? 0 : pn < 4 ? 1 : pn < 12 ? 2 : pn < 16 ? 3 : pn < 20 ? 4 : 2; }
struct EpiProj {
    static constexpr bool PERM = true;
    bf16* P; const f32x2* tret; const f32x2* tdiff;
    __device__ __forceinline__ void operator()(const f32x4 (&acc)[2][2][4][2], const pg8::Unit& u, int wr, int wc, int fr, int fq) const {
        const int ty = tile_type(u.pn), G = 4 * wc + fq;
        const float sc = ty == 1 ? QK_SCALE : ty == 3 ? QK_SCALE * LOG2E : 1.f;
        const bool rot = (ty == 0 || ty == 1) || ((ty == 3 || ty == 4) && wc == 0);
        const bool full = ty < 2;
        const int i0 = full ? 8 * (G & 7) : 8 * (fq & 1);
        const int d1 = full ? (G >> 3) * 128 + i0 : (fq >> 1) * 128 + i0, d2 = full ? d1 + 64 : d1 + 16;
#pragma unroll
        for (int ai = 0; ai < 2; ++ai) {
            f32x4 cst[4][4];
            if (rot) {
#pragma unroll
                for (int m = 0; m < 4; ++m) { const int t = (u.pm * 256 + ai * 128 + wr * 64 + m * 16 + fr) & 4095;
                    const f32x4* cs = (const f32x4*)((full ? tret + (size_t)(16 + t) * 64 : tdiff + (size_t)(16 + t) * 16) + i0);
                    cst[m][0] = cs[0]; cst[m][1] = cs[1]; cst[m][2] = cs[2]; cst[m][3] = cs[3]; }
            }
#pragma unroll
            for (int m = 0; m < 4; ++m) {
                const int R = u.pm * 256 + ai * 128 + wr * 64 + m * 16 + fr, b = R >> 12;
                bf16* rowp = P + (size_t)(R + 128 * (b + 1)) * NIN + u.pn * 256;
                const f32x4 a0 = acc[ai][0][m][0], a1 = acc[ai][0][m][1], b0 = acc[ai][1][m][0], b1 = acc[ai][1][m][1];
                if (rot) {
                    const f32x4 c01 = cst[m][0], c23 = cst[m][1], c45 = cst[m][2], c67 = cst[m][3];
                    u32x4 o1, o2;
#define ROT1(x1, x2, c, s) (((x1) * (c) - (x2) * (s)) * sc)
#define ROT2(x1, x2, c, s) (((x1) * (s) + (x2) * (c)) * sc)
                    o1.x = cvtpk(ROT1(a0[0], b0[0], c01[0], c01[1]), ROT1(a0[1], b0[1], c01[2], c01[3])); o1.y = cvtpk(ROT1(a0[2], b0[2], c23[0], c23[1]), ROT1(a0[3], b0[3], c23[2], c23[3]));
                    o1.z = cvtpk(ROT1(a1[0], b1[0], c45[0], c45[1]), ROT1(a1[1], b1[1], c45[2], c45[3])); o1.w = cvtpk(ROT1(a1[2], b1[2], c67[0], c67[1]), ROT1(a1[3], b1[3], c67[2], c67[3]));
                    o2.x = cvtpk(ROT2(a0[0], b0[0], c01[0], c01[1]), ROT2(a0[1], b0[1], c01[2], c01[3])); o2.y = cvtpk(ROT2(a0[2], b0[2], c23[0], c23[1]), ROT2(a0[3], b0[3], c23[2], c23[3]));
                    o2.z = cvtpk(ROT2(a1[0], b1[0], c45[0], c45[1]), ROT2(a1[1], b1[1], c45[2], c45[3])); o2.w = cvtpk(ROT2(a1[2], b1[2], c67[0], c67[1]), ROT2(a1[3], b1[3], c67[2], c67[3]));
#undef ROT1
#undef ROT2
                    *(u32x4*)(rowp + d1) = o1; *(u32x4*)(rowp + d2) = o2;
                } else {
                    u32x4 o1, o2;
                    o1.x = cvtpk(a0[0] * sc, a0[1] * sc); o1.y = cvtpk(a0[2] * sc, a0[3] * sc); o1.z = cvtpk(a1[0] * sc, a1[1] * sc); o1.w = cvtpk(a1[2] * sc, a1[3] * sc);
                    o2.x = cvtpk(b0[0] * sc, b0[1] * sc); o2.y = cvtpk(b0[2] * sc, b0[3] * sc); o2.z = cvtpk(b1[0] * sc, b1[1] * sc); o2.w = cvtpk(b1[2] * sc, b1[3] * sc);
                    *(u32x4*)(rowp + 8 * G) = o1; *(u32x4*)(rowp + 128 + 8 * G) = o2;
                }
            }
        }
    }
};
__device__ __forceinline__ void meta_proj_task(Frame& F, int task) {
    const int lane = F.lane, g = lane >> 4, li = lane & 15, w = F.wave;
    const int tsel = task >> 3, j8 = task & 7;
    const int pn = tsel < 2 ? 2 + tsel : tsel < 6 ? 4 + (tsel - 2) : 16 + (tsel - 6);
    const bf16* um = (const bf16*)(F.ws + WS_MISC + 4096);
    const bf16* wt = (const bf16*)(F.ws + WS_WIN);
    const bf16* ap = um + (size_t)li * DM + 8 * g + 256 * w;
    const bf16* bp0 = wt + (size_t)(pn * 256 + 16 * j8 + li) * DM + 8 * g + 256 * w;
    const bf16* bp1 = bp0 + (size_t)128 * DM;
    bf16x8 a[8], b0[8], b1[8];
#pragma unroll
    for (int s = 0; s < 8; ++s) { a[s] = *(const bf16x8*)(ap + 32 * s); b0[s] = *(const bf16x8*)(bp0 + 32 * s); b1[s] = *(const bf16x8*)(bp1 + 32 * s); }
    f32x4 accA = {0.f, 0.f, 0.f, 0.f}, accB = {0.f, 0.f, 0.f, 0.f};
#pragma unroll
    for (int s = 0; s < 8; ++s) { accA = __builtin_amdgcn_mfma_f32_16x16x32_bf16(a[s], b0[s], accA, 0, 0, 0); accB = __builtin_amdgcn_mfma_f32_16x16x32_bf16(a[s], b1[s], accB, 0, 0, 0); }
    LAS f32x4* red = (LAS f32x4*)F.lds;
    red[(w * 2 + 0) * 64 + lane] = accA; red[(w * 2 + 1) * 64 + lane] = accB;
    __syncthreads();
    if (w == 0) {
#pragma unroll
        for (int ww = 1; ww < 8; ++ww) { accA += red[(ww * 2 + 0) * 64 + lane]; accB += red[(ww * 2 + 1) * 64 + lane]; }
        const int ty = tile_type(pn), c = 16 * j8 + li;
        const f32x2* tret = (const f32x2*)(F.ws + WS_TAB_RET); const f32x2* tdiff = (const f32x2*)(F.ws + WS_TAB_DIFF);
        bf16* P = (bf16*)(F.ws + WS_P);
#pragma unroll
        for (int r = 0; r < 4; ++r) {
            const int row = 4 * g + r;
            float x1 = accA[r], x2 = accB[r]; int c1 = c, c2 = 128 + c;
            if (ty == 1) { const int head2 = c >> 6, i = c & 63; const f32x2 cs = tret[row * 64 + i]; const float y1 = (x1 * cs.x - x2 * cs.y) * QK_SCALE, y2 = (x1 * cs.y + x2 * cs.x) * QK_SCALE;
                x1 = y1; x2 = y2; c1 = head2 * 128 + i; c2 = c1 + 64; }
            else if (ty == 4 && c < 32) { const int comp = c >> 4, i = c & 15; const f32x2 cs = tdiff[row * 16 + i]; const float y1 = x1 * cs.x - x2 * cs.y, y2 = x1 * cs.y + x2 * cs.x;
                x1 = y1; x2 = y2; c1 = comp * 128 + i; c2 = c1 + 16; }
            const bf16 h1 = (bf16)f2bf(x1), h2 = (bf16)f2bf(x2);
#pragma unroll
            for (int b = 0; b < NB; ++b) { bf16* rowp = P + (size_t)(b * LPAD + 112 + row) * NIN + pn * 256; rowp[c1] = h1; rowp[c2] = h2; }
        }
    }
    __syncthreads();
}
struct EpiH1 {
    static constexpr bool PERM = false;
    const float* x; float* out; float* ss;
    __device__ __forceinline__ void operator()(const f32x4 (&acc)[2][2][4][2], const pg8::Unit& u, int wr, int wc, int fr, int fq) const {
        const int col0 = u.pn * 256 + wc * 32 + 4 * fq;
#pragma unroll
        for (int ai = 0; ai < 2; ++ai) {
            f32x4 xv[4][2][2];
#pragma unroll
            for (int m = 0; m < 4; ++m) { const size_t off = (size_t)(u.pm * 256 + ai * 128 + wr * 64 + m * 16 + fr) * DM + col0;
#pragma unroll
                for (int bj = 0; bj < 2; ++bj)
#pragma unroll
                    for (int n = 0; n < 2; ++n) xv[m][bj][n] = *(const f32x4*)(x + off + bj * 128 + n * 16); }
#pragma unroll
            for (int m = 0; m < 4; ++m) {
                const int R = u.pm * 256 + ai * 128 + wr * 64 + m * 16 + fr; const size_t off = (size_t)R * DM + col0; float s = 0.f;
#pragma unroll
                for (int bj = 0; bj < 2; ++bj)
#pragma unroll
                    for (int n = 0; n < 2; ++n) { const f32x4 h = xv[m][bj][n] + acc[ai][bj][m][n]; *(f32x4*)(out + off + bj * 128 + n * 16) = h;
                        s += (h[0] * h[0] + h[1] * h[1]) + (h[2] * h[2] + h[3] * h[3]); }
                s += __shfl_xor(s, 16); s += __shfl_xor(s, 32);
                if (fq == 0) ss[(size_t)R * 32 + u.pn * 4 + wc] = s;
            }
        }
    }
};
struct MoeSched {
    const LAS int* tb; const LAS int* cnt; const LAS unsigned* rowtab; const LAS int* pt; const int* list; int NT, x, j, nj;
    __device__ __forceinline__ bool next(int i, pg8::Unit& u) const {
        const int l = i * nj + j; if (l >= pt[8] * NT) return false;
        const int tq = l / NT, nt = l - tq * NT; int k = 0;
#pragma unroll
        for (int s = 1; s < 8; ++s) if (pt[s] <= tq) k = s;
        const int e = pt[16 + k]; u.pm = tb[e] + (tq - pt[k]); u.pn = e * NT + nt; u.aux = i; return true; }
    __device__ __forceinline__ unsigned rowoff(const pg8::Unit& u, int row) const { if (u.aux < 7) return rowtab[u.aux * 256 + row];
        const int e = u.pn / NT, r = (u.pm - tb[e]) * 256 + row; return (unsigned)list[(size_t)e * NTOK + (r < cnt[e] ? r : 0)] * (unsigned)(DM * 2); }
};
__device__ __forceinline__ float silu_f(float g) { return g * __builtin_amdgcn_rcpf(1.0f + __builtin_amdgcn_exp2f(-g * LOG2E)); }
struct EpiAct {
    static constexpr bool PERM = true;
    bf16* H;
    __device__ __forceinline__ void operator()(const f32x4 (&acc)[2][2][4][2], const pg8::Unit& u, int wr, int wc, int fr, int fq) const {
        const int nt = u.pn & 3, G = 4 * wc + fq; const bool half = false;
#pragma unroll
        for (int ai = 0; ai < 2; ++ai) { if (ai == 1 && half) break;
#pragma unroll
            for (int m = 0; m < 4; ++m) {
                const int row = u.pm * 256 + ai * 128 + wr * 64 + m * 16 + fr;
                const f32x4 g0 = acc[ai][0][m][0], g1 = acc[ai][0][m][1], u0 = acc[ai][1][m][0], u1 = acc[ai][1][m][1];
                u32x4 o; o.x = cvtpk(silu_f(g0[0]) * u0[0], silu_f(g0[1]) * u0[1]); o.y = cvtpk(silu_f(g0[2]) * u0[2], silu_f(g0[3]) * u0[3]);
                o.z = cvtpk(silu_f(g1[0]) * u1[0], silu_f(g1[1]) * u1[1]); o.w = cvtpk(silu_f(g1[2]) * u1[2], silu_f(g1[3]) * u1[3]);
                *(u32x4*)(H + (size_t)row * FF + nt * 128 + 8 * G) = o;
            } }
    }
};
struct EpiY {
    static constexpr bool PERM = true;
    bf16* Y; const float* wl; const LAS int* tb; const LAS int* cnt;
    __device__ __forceinline__ void operator()(const f32x4 (&acc)[2][2][4][2], const pg8::Unit& u, int wr, int wc, int fr, int fq) const {
        const int e = u.pn >> 3, nt = u.pn & 7, G = 4 * wc + fq, r0 = (u.pm - tb[e]) * 256, ce = cnt[e]; const bool half = r0 + 128 >= ce;
        float wv[2][4];
#pragma unroll
        for (int ai = 0; ai < 2; ++ai)
#pragma unroll
            for (int m = 0; m < 4; ++m) { const int r = r0 + ai * 128 + wr * 64 + m * 16 + fr; wv[ai][m] = r < ce ? wl[(size_t)e * NTOK + r] : 0.f; }
#pragma unroll
        for (int ai = 0; ai < 2; ++ai) { if (ai == 1 && half) break;
#pragma unroll
            for (int m = 0; m < 4; ++m) {
                const int rt = ai * 128 + wr * 64 + m * 16 + fr;
                const float w = wv[ai][m];
                bf16* rowp = Y + (size_t)(u.pm * 256 + rt) * DM + nt * 256 + 8 * G;
#pragma unroll
                for (int bj = 0; bj < 2; ++bj) { const f32x4 v0 = acc[ai][bj][m][0], v1 = acc[ai][bj][m][1];
                    u32x4 o; o.x = cvtpk(v0[0] * w, v0[1] * w); o.y = cvtpk(v0[2] * w, v0[3] * w); o.z = cvtpk(v1[0] * w, v1[1] * w); o.w = cvtpk(v1[2] * w, v1[3] * w);
                    *(u32x4*)(rowp + bj * 128) = o; }
            } }
    }
};
constexpr int AT_KS = 528, AT_VS = 544, AT_KB = 32 * AT_KS, AT_VB = 32 * AT_VS, AT_BUF = AT_KB + AT_VB, AT_SCR = 2 * AT_BUF;
static_assert(AT_SCR + NWAVES * 256 <= RING_BYTES, "attention LDS");
typedef short v4i16_t __attribute__((ext_vector_type(4)));
__device__ __forceinline__ s16x4 trr(const LAS unsigned char* p) { return __builtin_bit_cast(s16x4, __builtin_amdgcn_ds_read_tr16_b64_v4i16((LAS v4i16_t*)p)); }
#define MFMA16(a, b, c) __builtin_amdgcn_mfma_f32_16x16x32_bf16(a, b, c, 0, 0, 0)
#define BV8(lo, hi) (bf16x8){lo[0], lo[1], lo[2], lo[3], hi[0], hi[1], hi[2], hi[3]}
__device__ __forceinline__ float fexp2(float x) { return __builtin_amdgcn_exp2f(x); }

__device__ __forceinline__ void sm16(f32x4 (&s)[2], float& m, float& l, float& alpha, bf16x8& pa) {
    float mx = fmaxf(fmaxf(fmaxf(s[0][0], s[0][1]), fmaxf(s[0][2], s[0][3])), fmaxf(fmaxf(s[1][0], s[1][1]), fmaxf(s[1][2], s[1][3])));
    mx = xmax32(xmax16(mx));
    const float mn = fmaxf(m, mx); alpha = fexp2(m - mn); m = mn;
    float ps = 0.f;
#pragma unroll
    for (int kb = 0; kb < 2; ++kb)
#pragma unroll
        for (int r = 0; r < 4; ++r) { s[kb][r] = fexp2(s[kb][r] - mn); ps += s[kb][r]; }
    l = l * alpha + ps;
    u32x4 w; w.x = cvtpk(s[0][0], s[0][1]); w.y = cvtpk(s[0][2], s[0][3]); w.z = cvtpk(s[1][0], s[1][1]); w.w = cvtpk(s[1][2], s[1][3]);
    pa = __builtin_bit_cast(bf16x8, w);
}

constexpr int DA_RS = 1056, DA_BUF = 64 * DA_RS, DA_SCR = 2 * DA_BUF;
static_assert(DA_SCR + NWAVES * 128 <= LDSCTL_OFF && 8 * 16 * 64 * 16 <= DA_SCR, "attention LDS");
__device__ __forceinline__ void glds16s(unsigned voff, const void* sbase, unsigned lds_dst) { unsigned keep;
    asm volatile("s_mov_b32 %0, m0\n\ts_mov_b32 m0, %3\n\ts_nop 0\n\tglobal_load_lds_dwordx4 %1, %2\n\ts_mov_b32 m0, %0" : "=&s"(keep) : "v"(voff), "s"(sbase), "s"(lds_dst) : "memory"); }
__device__ __forceinline__ const char* uniform_ptr(const char* p) { const unsigned long long v = (unsigned long long)(uintptr_t)p;
    return (const char*)(uintptr_t)(((unsigned long long)(unsigned)__builtin_amdgcn_readfirstlane((int)(v >> 32)) << 32) | (unsigned)__builtin_amdgcn_readfirstlane((int)(unsigned)v)); }
__device__ __forceinline__ void diff_unit(Frame& F, int b, int h, int qb) {
    LAS unsigned char* lds = F.lds;
    const int lane = F.lane, w = F.wave, g = lane >> 4, li = lane & 15, rg = w & 3, cp = w >> 2;
    const bf16* Pb = (const bf16*)(F.ws + WS_P) + (size_t)b * LPAD * NIN;
    const int Q0 = 128 + 128 * qb, qrow = Q0 + 32 * rg, ntiles = 3 + 2 * qb;
    bf16x8 qf[2][4];
#pragma unroll
    for (int rb = 0; rb < 2; ++rb) { const bf16* qp = Pb + (size_t)(qrow + 16 * rb + li) * NIN + C_DQ + h * 256 + cp * 128 + 8 * g;
#pragma unroll
        for (int s = 0; s < 4; ++s) qf[rb][s] = *(const bf16x8*)(qp + 32 * s); }
    const char* gk = uniform_ptr((const char*)Pb + (size_t)((C_DK + h * 256) * 2));
    const unsigned dvo = (unsigned)(16 * lane + (lane >= 32 ? ((C_DV - C_DK) * 2 - 512) : 0));
    const unsigned ldsbase = (unsigned)(uintptr_t)lds;
#define DA_DMA(l0, bf) do { _Pragma("unroll") for (int i_ = 0; i_ < 8; ++i_) glds16s(dvo, gk + (size_t)((l0) + w + 8 * i_) * (NIN * 2), (unsigned)__builtin_amdgcn_readfirstlane(ldsbase + (bf) * DA_BUF + (w + 8 * i_) * DA_RS)); } while (0)
#define DA_WAITBAR() asm volatile("s_waitcnt vmcnt(0) lgkmcnt(0)\n\ts_barrier" ::: "memory")
    const int kra = li * DA_RS + cp * 256 + g * 16;
    const int vra = 512 + (4 * g + (li >> 2)) * DA_RS + (li & 3) * 8;
    LAS float* scr = (LAS float*)(lds + DA_SCR + w * 128);
    float m[2] = {-1e30f, -1e30f}, l[2] = {0.f, 0.f};
    f32x4 o[2][16];
#pragma unroll
    for (int rb = 0; rb < 2; ++rb)
#pragma unroll
        for (int c = 0; c < 16; ++c) o[rb][c] = (f32x4){0.f, 0.f, 0.f, 0.f};
    DA_DMA(64, 0); DA_WAITBAR();
    for (int j = 0; j < ntiles; ++j) {
        const int l0 = 64 + 64 * j; const LAS unsigned char* tb = lds + (j & 1) * DA_BUF;
        if (j + 1 < ntiles) DA_DMA(l0 + 64, (j + 1) & 1);
        if (l0 <= qrow + 31) {
            f32x4 s[2][4];
#pragma unroll
            for (int kb = 0; kb < 4; ++kb) { s[0][kb] = (f32x4){0.f, 0.f, 0.f, 0.f}; s[1][kb] = (f32x4){0.f, 0.f, 0.f, 0.f};
#pragma unroll
                for (int sd = 0; sd < 4; ++sd) { const bf16x8 a = *(const LAS bf16x8*)(tb + kra + kb * 16 * DA_RS + sd * 64); s[0][kb] = MFMA16(a, qf[0][sd], s[0][kb]); s[1][kb] = MFMA16(a, qf[1][sd], s[1][kb]); } }
            if (j == 0 || l0 + 63 > qrow) {
#pragma unroll
                for (int rb = 0; rb < 2; ++rb)
#pragma unroll
                    for (int kb = 0; kb < 4; ++kb)
#pragma unroll
                        for (int r = 0; r < 4; ++r) { const int key = l0 + 16 * kb + 4 * g + r; if (key < 112 || key > qrow + 16 * rb + li) s[rb][kb][r] = -1e30f; }
            }
            bf16x8 pa[2][2]; float alpha[2];
#pragma unroll
            for (int rb = 0; rb < 2; ++rb) {
                float mx = fmaxf(fmaxf(s[rb][0][0], s[rb][0][1]), fmaxf(s[rb][0][2], s[rb][0][3]));
#pragma unroll
                for (int kb = 1; kb < 4; ++kb) mx = fmaxf(fmaxf(mx, fmaxf(s[rb][kb][0], s[rb][kb][1])), fmaxf(s[rb][kb][2], s[rb][kb][3]));
                mx = xmax32(xmax16(mx));
                const float mn = fmaxf(m[rb], mx); alpha[rb] = fexp2(m[rb] - mn); m[rb] = mn;
                float ps = 0.f;
#pragma unroll
                for (int kb = 0; kb < 4; ++kb)
#pragma unroll
                    for (int r = 0; r < 4; ++r) { s[rb][kb][r] = fexp2(s[rb][kb][r] - mn); ps += s[rb][kb][r]; }
                l[rb] = l[rb] * alpha[rb] + ps;
#pragma unroll
                for (int t = 0; t < 2; ++t) { u32x4 pw; pw.x = cvtpk(s[rb][2 * t][0], s[rb][2 * t][1]); pw.y = cvtpk(s[rb][2 * t][2], s[rb][2 * t][3]); pw.z = cvtpk(s[rb][2 * t + 1][0], s[rb][2 * t + 1][1]); pw.w = cvtpk(s[rb][2 * t + 1][2], s[rb][2 * t + 1][3]);
                    pa[rb][t] = __builtin_bit_cast(bf16x8, pw); }
            }
            if (__any(alpha[0] < 1.f || alpha[1] < 1.f)) {
                if (g == 0) { scr[li] = alpha[0]; scr[16 + li] = alpha[1]; }
                LDS_WAIT();
                const f32x4 a0 = *(const LAS f32x4*)(scr + 4 * g), a1 = *(const LAS f32x4*)(scr + 16 + 4 * g);
#pragma unroll
                for (int c = 0; c < 16; ++c) { o[0][c] *= a0; o[1][c] *= a1; }
                LDS_WAIT();
            }
#pragma unroll
            for (int t = 0; t < 2; ++t)
#pragma unroll
                for (int c = 0; c < 16; ++c) { const s16x4 lo = trr(tb + vra + (32 * t) * DA_RS + c * 32), hi = trr(tb + vra + (32 * t + 16) * DA_RS + c * 32); const bf16x8 bv = BV8(lo, hi);
                    o[0][c] = MFMA16(pa[0][t], bv, o[0][c]); o[1][c] = MFMA16(pa[1][t], bv, o[1][c]); if ((c & 3) == 3) __builtin_amdgcn_sched_barrier(0); }
        }
        DA_WAITBAR();
    }
    { const float lam = *(const float*)(F.ws + WS_MISC);
#pragma unroll
      for (int rb = 0; rb < 2; ++rb) { const float lt = xsum32(xsum16(l[rb])); if (g == 0) scr[16 * rb + li] = cp ? lam / lt : 1.0f / lt; }
      LDS_WAIT();
      const f32x4 f0 = *(const LAS f32x4*)(scr + 4 * g), f1 = *(const LAS f32x4*)(scr + 16 + 4 * g);
#pragma unroll
      for (int c = 0; c < 16; ++c) { o[0][c] *= f0; o[1][c] *= f1; } }
    LAS f32x4* xb = (LAS f32x4*)lds + (size_t)rg * 2048 + lane;
    if (cp) {
#pragma unroll
        for (int rb = 0; rb < 2; ++rb)
#pragma unroll
            for (int c = 0; c < 16; ++c) xb[(rb * 16 + c) * 64] = o[rb][c];
    }
    __syncthreads();
    if (!cp) {
        const float* gs = F.in[9];
        float gv16[16];
#pragma unroll
        for (int c = 0; c < 16; ++c) gv16[c] = gs[16 * c + li] * (1.0f - LAMBDA_INIT);
#pragma unroll
        for (int rb = 0; rb < 2; ++rb) {
            f32x4 ss = {0.f, 0.f, 0.f, 0.f};
#pragma unroll
            for (int c = 0; c < 16; ++c) { o[rb][c] -= xb[(rb * 16 + c) * 64]; ss += o[rb][c] * o[rb][c]; }
#pragma unroll
            for (int r = 0; r < 4; ++r) { float v = ss[r]; v += __shfl_xor(v, 1); v += __shfl_xor(v, 2); v += __shfl_xor(v, 4); v += __shfl_xor(v, 8); ss[r] = 1.0f / sqrtf(v * (1.f / 256.f) + EPS); }
            bf16* mx = (bf16*)(F.ws + WS_MIXED) + (size_t)(b * SEQ + 128 * qb + 32 * rg + 16 * rb + 4 * g) * DM + 1024 + h * 256 + li;
#pragma unroll
            for (int c = 0; c < 16; ++c) { const float gv = gv16[c];
#pragma unroll
                for (int r = 0; r < 4; ++r) mx[(size_t)r * DM + 16 * c] = (bf16)f2bf(o[rb][c][r] * ss[r] * gv); }
        }
    }
    __syncthreads();
#undef DA_DMA
#undef DA_WAITBAR
}

__device__ __forceinline__ float ret_log2g(int h) { return log2f(1.0f - 1.0f / (float)(32 << h)); }
__device__ __forceinline__ void ret_kv_unit(Frame& F, int b, int h, int c  ) {
    LAS unsigned char* lds = F.lds;
    const int tid = F.tid, lane = F.lane, w = F.wave, g = lane >> 4, li = lane & 15;
    const bf16* Pb = (const bf16*)(F.ws + WS_P) + (size_t)(b * LPAD + 128 * c) * NIN;
    const float lg = ret_log2g(h);
    const int krow = tid >> 4, kch = tid & 15, srow = tid >> 5, sch = tid & 31;
    const bf16* kg = Pb + (size_t)krow * NIN + C_RK + h * 128 + kch * 8;
    const bf16* vg = Pb + (size_t)srow * NIN + C_RV + h * 256 + sch * 8;
    const int kst = krow * AT_KS + kch * 16, vst = AT_KB + srow * AT_VS + sch * 16;
    u32x4 st[3];
#define K_LOADT(i) do { const size_t o_ = (size_t)(32 * (i)) * NIN; st[0] = *(const u32x4*)(kg + o_); st[1] = *(const u32x4*)(vg + o_); st[2] = *(const u32x4*)(vg + o_ + 16 * NIN); } while (0)
#define K_WRITET(bf, i) do { LAS unsigned char* d_ = lds + (bf) * AT_BUF; const float z_ = fexp2((float)(127 - 32 * (i) - krow) * lg); u32x4 k_; \
        k_.x = cvtpk(bf_lo(st[0].x) * z_, bf_hi(st[0].x) * z_); k_.y = cvtpk(bf_lo(st[0].y) * z_, bf_hi(st[0].y) * z_); k_.z = cvtpk(bf_lo(st[0].z) * z_, bf_hi(st[0].z) * z_); k_.w = cvtpk(bf_lo(st[0].w) * z_, bf_hi(st[0].w) * z_); \
        *(LAS u32x4*)(d_ + kst) = k_; *(LAS u32x4*)(d_ + vst) = st[1]; *(LAS u32x4*)(d_ + vst + 16 * AT_VS) = st[2]; } while (0)
    const int ara = (4 * g + (li >> 2)) * AT_KS + (16 * w + 4 * (li & 3)) * 2;
    const int vra = AT_KB + (4 * g + (li >> 2)) * AT_VS + (li & 3) * 8;
    f32x4 acc[16];
#pragma unroll
    for (int cc = 0; cc < 16; ++cc) acc[cc] = (f32x4){0.f, 0.f, 0.f, 0.f};
    K_LOADT(0); K_WRITET(0, 0); K_LOADT(1); __syncthreads();
#pragma unroll
    for (int i = 0; i < 4; ++i) {
        const LAS unsigned char* tb = lds + (i & 1) * AT_BUF;
        const s16x4 alo = trr(tb + ara), ahi = trr(tb + ara + 16 * AT_KS); const bf16x8 af = BV8(alo, ahi);
        if (i + 1 < 4) K_WRITET((i + 1) & 1, i + 1);
        if (i + 2 < 4) K_LOADT(i + 2);
#pragma unroll
        for (int cc = 0; cc < 16; ++cc) { const s16x4 lo = trr(tb + vra + cc * 32), hi = trr(tb + vra + 16 * AT_VS + cc * 32); acc[cc] = MFMA16(af, BV8(lo, hi), acc[cc]); }
        __syncthreads();
    }
#undef K_LOADT
#undef K_WRITET
    float* kv = (float*)(F.ws + WS_KV) + ((size_t)((b * 4 + h) * 32 + c) * 128 + 16 * w + 4 * g) * 256 + li;
#pragma unroll
    for (int cc = 0; cc < 16; ++cc)
#pragma unroll
        for (int r = 0; r < 4; ++r) kv[(size_t)r * 256 + 16 * cc] = acc[cc][r];
}
__device__ __forceinline__ void ret_scan(Frame& F) {
    const int gt = F.gw * 64 + F.lane, ngt = F.ngw * 64;
    for (int e = gt; e < 16 * 128 * 64; e += ngt) {
        const int bh = e >> 13, rem = e & 8191;
        const float dec = fexp2(128.0f * ret_log2g(bh & 3));
        const f32x4* kv = (const f32x4*)(F.ws + WS_KV) + (size_t)bh * 32 * 8192 + rem;
        u32x2* sb = (u32x2*)(F.ws + WS_S) + (size_t)bh * 32 * 8192 + rem;
        f32x4 s = {0.f, 0.f, 0.f, 0.f};
#pragma unroll 8
        for (int c = 0; c < 32; ++c) { s = s * dec + kv[(size_t)c * 8192]; u32x2 o; o.x = cvtpk(s[0], s[1]); o.y = cvtpk(s[2], s[3]); sb[(size_t)c * 8192] = o; }
    }
}
__device__ __forceinline__ void ret_out_unit(Frame& F, int b, int h, int c  ) {
    LAS unsigned char* lds = F.lds;
    const int tid = F.tid, lane = F.lane, w = F.wave, g = lane >> 4, li = lane & 15;
    const bf16* Pb = (const bf16*)(F.ws + WS_P) + (size_t)(b * LPAD + 128 * c) * NIN;
    const bf16* Sb = (const bf16*)(F.ws + WS_S) + (size_t)((b * 4 + h) * 32 + (c - 1)) * 128 * 256;
    const float lg = ret_log2g(h);
    bf16x8 qf[4];
    { const bf16* qp = Pb + (size_t)(16 * w + li) * NIN + C_RQ + h * 128 + 8 * g;
#pragma unroll
      for (int s = 0; s < 4; ++s) qf[s] = *(const bf16x8*)(qp + 32 * s); }
    const int krow = tid >> 4, kch = tid & 15, srow = tid >> 5, sch = tid & 31;
    const int rho = 16 * ((srow >> 2) & 1) + 4 * (srow >> 3) + (srow & 3);
    const bf16* sg = Sb + (size_t)srow * 256 + sch * 8;
    const bf16* kg = Pb + (size_t)krow * NIN + C_RK + h * 128 + kch * 8;
    const bf16* vg = Pb + (size_t)srow * NIN + C_RV + h * 256 + sch * 8;
    const int kst = krow * AT_KS + kch * 16, vst = AT_KB + srow * AT_VS + sch * 16, sst = AT_KB + rho * AT_VS + sch * 16;
    u32x4 st[3];
#define R_LOAD(j) do { if ((j) < 4) { const size_t o_ = (size_t)(32 * (j)) * 256; st[1] = *(const u32x4*)(sg + o_); st[2] = *(const u32x4*)(sg + o_ + 16 * 256); } \
        else { const size_t o_ = (size_t)(32 * ((j) - 4)) * NIN; st[0] = *(const u32x4*)(kg + o_); st[1] = *(const u32x4*)(vg + o_); st[2] = *(const u32x4*)(vg + o_ + 16 * NIN); } } while (0)
#define R_WRITE(bf, j) do { LAS unsigned char* d_ = lds + (bf) * AT_BUF; if ((j) < 4) { *(LAS u32x4*)(d_ + sst) = st[1]; *(LAS u32x4*)(d_ + sst + 8 * AT_VS) = st[2]; } \
        else { *(LAS u32x4*)(d_ + kst) = st[0]; *(LAS u32x4*)(d_ + vst) = st[1]; *(LAS u32x4*)(d_ + vst + 16 * AT_VS) = st[2]; } } while (0)
    const int kra = li * AT_KS + g * 16;
    const int vra = AT_KB + (4 * g + (li >> 2)) * AT_VS + (li & 3) * 8;
    f32x4 o[16];
#pragma unroll
    for (int cc = 0; cc < 16; ++cc) o[cc] = (f32x4){0.f, 0.f, 0.f, 0.f};
    R_LOAD(0); R_WRITE(0, 0); R_LOAD(1); __syncthreads();
#pragma unroll
    for (int j = 0; j < 8; ++j) {
        const LAS unsigned char* tb = lds + (j & 1) * AT_BUF;
        if (j < 4) {
            if (j + 1 < 8) R_WRITE((j + 1) & 1, j + 1);
            if (j + 2 < 8) R_LOAD(j + 2);
#pragma unroll
            for (int cc = 0; cc < 16; ++cc) { const s16x4 lo = trr(tb + vra + cc * 32), hi = trr(tb + vra + 16 * AT_VS + cc * 32); o[cc] = MFMA16(qf[j & 3], BV8(lo, hi), o[cc]); }
            if (j == 3) {
                f32x4 xi;
#pragma unroll
                for (int r = 0; r < 4; ++r) xi[r] = fexp2((float)(16 * w + 4 * g + r + 1) * lg);
#pragma unroll
                for (int cc = 0; cc < 16; ++cc) o[cc] *= xi;
            }
        } else {
            const int i = j - 4;
            bf16x8 pa; bool live = (32 * i <= 16 * w + 15);
            if (live) {
                f32x4 s[2];
#pragma unroll
                for (int kb = 0; kb < 2; ++kb) { s[kb] = (f32x4){0.f, 0.f, 0.f, 0.f};
#pragma unroll
                    for (int sd = 0; sd < 4; ++sd) { const bf16x8 a = *(const LAS bf16x8*)(tb + kra + kb * 16 * AT_KS + sd * 64); s[kb] = MFMA16(a, qf[sd], s[kb]); } }
#pragma unroll
                for (int kb = 0; kb < 2; ++kb)
#pragma unroll
                    for (int r = 0; r < 4; ++r) { const int d = (16 * w + li) - (32 * i + 16 * kb + 4 * g + r); s[kb][r] = d >= 0 ? s[kb][r] * fexp2((float)d * lg) : 0.f; }
                u32x4 pw; pw.x = cvtpk(s[0][0], s[0][1]); pw.y = cvtpk(s[0][2], s[0][3]); pw.z = cvtpk(s[1][0], s[1][1]); pw.w = cvtpk(s[1][2], s[1][3]);
                pa = __builtin_bit_cast(bf16x8, pw);
            }
            if (j + 1 < 8) R_WRITE((j + 1) & 1, j + 1);
            if (j + 2 < 8) R_LOAD(j + 2);
            if (live) {
#pragma unroll
                for (int cc = 0; cc < 16; ++cc) { const s16x4 lo = trr(tb + vra + cc * 32), hi = trr(tb + vra + 16 * AT_VS + cc * 32); o[cc] = MFMA16(pa, BV8(lo, hi), o[cc]); }
            }
        }
        __syncthreads();
    }
#undef R_LOAD
#undef R_WRITE
    f32x4 ss = {0.f, 0.f, 0.f, 0.f};
#pragma unroll
    for (int cc = 0; cc < 16; ++cc) ss += o[cc] * o[cc];
#pragma unroll
    for (int r = 0; r < 4; ++r) { float v = ss[r]; v += __shfl_xor(v, 1); v += __shfl_xor(v, 2); v += __shfl_xor(v, 4); v += __shfl_xor(v, 8); ss[r] = 1.0f / sqrtf(v * (1.f / 256.f) + EPS); }
    const bf16* gp = Pb + (size_t)(16 * w + 4 * g) * NIN + C_RG + h * 256 + li;
    bf16* mx = (bf16*)(F.ws + WS_MIXED) + (size_t)(b * SEQ + 128 * (c - 1) + 16 * w + 4 * g) * DM + h * 256 + li;
    unsigned gq[16][2];
#pragma unroll
    for (int cc = 0; cc < 16; ++cc)
#pragma unroll
        for (int r2 = 0; r2 < 2; ++r2) gq[cc][r2] = (unsigned)gp[(size_t)(2 * r2) * NIN + 16 * cc] | ((unsigned)gp[(size_t)(2 * r2 + 1) * NIN + 16 * cc] << 16);
#pragma unroll
    for (int cc = 0; cc < 16; ++cc)
#pragma unroll
        for (int r = 0; r < 4; ++r) { const float gt = (r & 1) ? bf_hi(gq[cc][r >> 1]) : bf_lo(gq[cc][r >> 1]); mx[(size_t)r * DM + 16 * cc] = (bf16)f2bf(silu_f(gt) * o[cc][r] * ss[r]); }
}
__device__ __forceinline__ void router_select(Frame& F, const LAS float* row, int tok) {
    int gs = 0; float gm = row[64];
#pragma unroll
    for (int j = 1; j < 8; ++j) { const float v = row[64 + j]; if (v > gm) { gm = v; gs = j; } }
    float gsum = 0.f;
#pragma unroll
    for (int j = 0; j < 8; ++j) gsum += __expf(row[64 + j] - gm);
    const float ggate = 1.0f / gsum;
    const LAS float* er = row + 8 * gs;
    int i1 = 0; float e1 = er[0];
#pragma unroll
    for (int j = 1; j < 8; ++j) { const float v = er[j]; if (v > e1) { e1 = v; i1 = j; } }
    int i2 = -1; float e2 = -3.0e38f;
#pragma unroll
    for (int j = 0; j < 8; ++j) { const float v = er[j]; if (j != i1 && v > e2) { e2 = v; i2 = j; } }
    const float t = __expf(e2 - e1), pa = 1.0f / (1.0f + t), pb = t * pa;
    const int ea = 8 * gs + i1, eb = 8 * gs + i2;
    gu32* cnt = F.ctl + CW_CNT + 32 * F.dup;
    const int ra = (int)__hip_atomic_fetch_add(cnt + 64 * ea, 1u, RLX_AGENT), rb2 = (int)__hip_atomic_fetch_add(cnt + 64 * eb, 1u, RLX_AGENT);
    int* list = (int*)(F.ws + (F.dup ? WS_KV : WS_LIST)); float* wl = (float*)(F.ws + (F.dup ? WS_KV + 4 * MiB : WS_WL));
    list[(size_t)ea * NTOK + ra] = tok; wl[(size_t)ea * NTOK + ra] = ggate * pa;
    list[(size_t)eb * NTOK + rb2] = tok; wl[(size_t)eb * NTOK + rb2] = ggate * pb;
    ((int4*)(F.ws + (F.dup ? WS_KV + 8 * MiB : WS_TOKSLOT)))[tok] = make_int4(ea, ra, eb, rb2);
}
__device__ __forceinline__ void router_task(Frame& F, int task) {
    const int lane = F.lane, g = lane >> 4, li = lane & 15, w = F.wave, r0 = 64 * task, k0 = 256 * w;
    const f32x4* ss = (const f32x4*)(F.ws + WS_SSP);
    const float* h1 = F.out + (size_t)(r0 + li) * DM + k0 + 8 * g;
    float rstd[4];
#pragma unroll
    for (int rb = 0; rb < 4; ++rb) { const f32x4* p = ss + (size_t)(r0 + 16 * rb + li) * 8; float t = 0.f;
#pragma unroll
        for (int q = 0; q < 8; ++q) { const f32x4 v = p[q]; t += (v[0] + v[1]) + (v[2] + v[3]); }
        rstd[rb] = 1.0f / sqrtf(t * (1.f / DM) + EPS); }
    const float* g2 = F.in[10] + k0 + 8 * g;
    bf16* up = (bf16*)(F.ws + WS_U) + (size_t)(r0 + li) * DM + k0 + 8 * g;
    const bf16* whi = (const bf16*)(F.ws + WS_WR) + (size_t)li * DM + k0 + 8 * g; const bf16* wlo = whi + 80 * DM;
    f32x4 acc[4][5];
#pragma unroll
    for (int rb = 0; rb < 4; ++rb)
#pragma unroll
        for (int cb = 0; cb < 5; ++cb) acc[rb][cb] = (f32x4){0.f, 0.f, 0.f, 0.f};
    const __amdgpu_buffer_rsrc_t rsH = __builtin_amdgcn_make_buffer_rsrc((void*)(F.out + (size_t)r0 * DM + k0), (short)0, 64 * DM * 4, 0x00020000);
    const __amdgpu_buffer_rsrc_t rsW = __builtin_amdgcn_make_buffer_rsrc((void*)((bf16*)(F.ws + WS_WR) + k0), (short)0, 160 * DM * 2, 0x00020000);
    const __amdgpu_buffer_rsrc_t rsU = __builtin_amdgcn_make_buffer_rsrc((void*)((bf16*)(F.ws + WS_U) + (size_t)r0 * DM + k0), (short)0, 64 * DM * 2, 0x00020000);
    const unsigned hL = (unsigned)(li * DM + 8 * g) * 4u, wL = (unsigned)(li * DM + 8 * g) * 2u;
    const char* gB = (const char*)(F.in[10] + k0); const unsigned gL = (unsigned)(8 * g) * 4u;
#define RT_X(rb, s, j) __builtin_bit_cast(f32x4, __builtin_amdgcn_raw_buffer_load_b128(rsH, hL, (unsigned)((16 * (rb)) * DM * 4 + 128 * (s) + 16 * (j)), 0))
#define RT_W(lo, cb, s) __builtin_bit_cast(bf16x8, __builtin_amdgcn_raw_buffer_load_b128(rsW, wL, (unsigned)((lo) * 80 * DM * 2 + (16 * (cb)) * DM * 2 + 64 * (s)), 0))
    f32x4 xa[4][2], xb[4][2];
#pragma unroll
    for (int rb = 0; rb < 4; ++rb) { xa[rb][0] = RT_X(rb, 0, 0); xa[rb][1] = RT_X(rb, 0, 1); }
    bf16x8 bh[5], bl[5];
#pragma unroll
    for (int cb = 0; cb < 5; ++cb) { bh[cb] = RT_W(0, cb, 0); bl[cb] = RT_W(1, cb, 0); }
    f32x4 ga = *(const f32x4*)(gB + gL), gb = *(const f32x4*)(gB + 16 + gL);
#define RT_STEP(s, XC, XN) do { \
        const int sn = (s) + 1 < 8 ? (s) + 1 : 7;                    \
        _Pragma("unroll") for (int rb = 0; rb < 4; ++rb) { XN[rb][0] = RT_X(rb, sn, 0); XN[rb][1] = RT_X(rb, sn, 1); } \
        __builtin_amdgcn_sched_barrier(0); \
        bf16x8 ah[4], al[4]; \
        _Pragma("unroll") for (int rb = 0; rb < 4; ++rb) { \
            const f32x4 v0 = XC[rb][0] * rstd[rb] * ga, v1 = XC[rb][1] * rstd[rb] * gb; \
            u32x4 hw; hw.x = cvtpk(v0[0], v0[1]); hw.y = cvtpk(v0[2], v0[3]); hw.z = cvtpk(v1[0], v1[1]); hw.w = cvtpk(v1[2], v1[3]); \
            u32x4 lw; lw.x = cvtpk(v0[0] - bf_lo(hw.x), v0[1] - bf_hi(hw.x)); lw.y = cvtpk(v0[2] - bf_lo(hw.y), v0[3] - bf_hi(hw.y)); \
            lw.z = cvtpk(v1[0] - bf_lo(hw.z), v1[1] - bf_hi(hw.z)); lw.w = cvtpk(v1[2] - bf_lo(hw.w), v1[3] - bf_hi(hw.w)); \
            __builtin_amdgcn_raw_buffer_store_b128(hw, rsU, wL, (unsigned)((16 * rb) * DM * 2 + 64 * (s)), 0); \
            ah[rb] = __builtin_bit_cast(bf16x8, hw); al[rb] = __builtin_bit_cast(bf16x8, lw); } \
        ga = *(const f32x4*)(gB + (size_t)(128 * sn) + gL); gb = *(const f32x4*)(gB + (size_t)(128 * sn + 16) + gL); \
        __builtin_amdgcn_sched_barrier(0); \
        _Pragma("unroll") for (int cb = 0; cb < 5; ++cb) { \
            _Pragma("unroll") for (int rb = 0; rb < 4; ++rb) acc[rb][cb] = MFMA16(ah[rb], bh[cb], acc[rb][cb]); \
            _Pragma("unroll") for (int rb = 0; rb < 4; ++rb) acc[rb][cb] = MFMA16(al[rb], bh[cb], acc[rb][cb]); \
            _Pragma("unroll") for (int rb = 0; rb < 4; ++rb) acc[rb][cb] = MFMA16(ah[rb], bl[cb], acc[rb][cb]); \
            __builtin_amdgcn_sched_barrier(0); \
            bh[cb] = RT_W(0, cb, sn); bl[cb] = RT_W(1, cb, sn); } \
        __builtin_amdgcn_sched_barrier(0); } while (0)
#pragma nounroll
    for (int s = 0; s < 8; s += 2) { RT_STEP(s, xa, xb); RT_STEP(s + 1, xb, xa); }
#undef RT_STEP
#undef RT_X
#undef RT_W
    LAS float* part = (LAS float*)F.lds;
    LAS float* red = part + 8 * 2560;
#pragma unroll
    for (int half = 0; half < 2; ++half) {
        if (half) __syncthreads();
#pragma unroll
        for (int rb = 0; rb < 2; ++rb)
#pragma unroll
            for (int cb = 0; cb < 5; ++cb)
#pragma unroll
                for (int r = 0; r < 4; ++r) part[w * 2560 + (16 * rb + 4 * g + r) * 80 + 16 * cb + li] = acc[2 * half + rb][cb][r];
        __syncthreads();
        for (int e = F.tid; e < 2560; e += NWAVES * 64) { float t = part[e];
#pragma unroll
            for (int ww = 1; ww < 8; ++ww) t += part[ww * 2560 + e];
            red[half * 2560 + e] = t; }
    }
    __syncthreads();
    if (w == 0) router_select(F, red + lane * 80, r0 + lane);
    __syncthreads();
}
__device__ __forceinline__ void moe_tables(Frame& F, int x) {
    LAS int* tb = (LAS int*)(F.lds + MOE_TAB_OFF); LAS int* cn = tb + 128; LAS int* pt = tb + 256;
    __syncthreads();
    if (F.tid < 64) {
        const int e = F.tid, c = (int)__hip_atomic_load(F.ctl + CW_CNT + 64 * e, RLX_AGENT), t = (c + 255) >> 8;
        cn[e] = c;
        int incl = t;
#pragma unroll
        for (int o = 1; o < 64; o <<= 1) { const int v = __shfl_up(incl, o); if (e >= o) incl += v; }
        tb[e] = incl - t; if (e == 63) tb[64] = incl;
        int rank = 0;
        for (int o = 0; o < 64; ++o) { const int to = __shfl(t, o); rank += (to > t || (to == t && o < e)) ? 1 : 0; }
        if ((rank & 7) == x) { pt[16 + (rank >> 3)] = e; pt[24 + (rank >> 3)] = t; }
    }
    __syncthreads();
    if (F.tid == 0) { int b = 0; for (int k = 0; k < 8; ++k) { pt[k] = b; b += pt[24 + k]; } pt[8] = b; }
    __syncthreads();
}
template <bool WITH_Y> __device__ __forceinline__ void final_row(Frame& F, int tok, const LAS int* tb) {
    const int lane = F.lane;
    int4 ts = make_int4(0, 0, 0, 0); if (WITH_Y) ts = ((const int4*)(F.ws + WS_TOKSLOT))[tok];
    const bf16* Y = (const bf16*)(F.ws + WS_Y);
    const u32x2* ya = (const u32x2*)(Y + (size_t)(WITH_Y ? tb[ts.x] * 256 + ts.y : 0) * DM) + lane; const u32x2* yb = (const u32x2*)(Y + (size_t)(WITH_Y ? tb[ts.z] * 256 + ts.w : 0) * DM) + lane;
    f32x4* hr = (f32x4*)(F.out + (size_t)tok * DM) + lane; f32x4* ho = F.dup ? (f32x4*)((float*)(F.ws + WS_U) + (size_t)tok * DM) + lane : hr;
    f32x4 v[8]; float s = 0.f;
#pragma unroll
    for (int j = 0; j < 8; ++j) { f32x4 h = hr[64 * j];
        if (WITH_Y) { const u32x2 a = ya[64 * j], b = yb[64 * j]; h[0] += bf_lo(a.x) + bf_lo(b.x); h[1] += bf_hi(a.x) + bf_hi(b.x); h[2] += bf_lo(a.y) + bf_lo(b.y); h[3] += bf_hi(a.y) + bf_hi(b.y); }
        v[j] = h; s += (h[0] * h[0] + h[1] * h[1]) + (h[2] * h[2] + h[3] * h[3]); }
    const float r = 1.0f / sqrtf(wave_sum(s) * (1.f / DM) + EPS);
    const f32x4* gf = (const f32x4*)F.in[16] + lane;
#pragma unroll
    for (int j = 0; j < 8; ++j) ho[64 * j] = v[j] * r * gf[64 * j];
}
#ifndef MK_N_LAUNCHES
#define MK_N_LAUNCHES 1
#endif
#ifndef MK_PHASE_MASK
#define MK_PHASE_MASK 0x3ff
#endif
#ifndef MK_DUP_MASK
#define MK_DUP_MASK 0
#endif
#ifndef MK_REP_DIFF
#define MK_REP_DIFF 1
#endif
#ifndef MK_REP_RET
#define MK_REP_RET 1
#endif
#ifndef MK_BRINGUP
#define MK_BRINGUP 3
#endif
constexpr int N_PHASES = 10;
struct Args { const float* in[17]; float* out; unsigned char* ws; int ph_lo, ph_hi, dup, pad; };
__global__ void __launch_bounds__(NWAVES * 64, 2) mk_fwd(Args args) {
    extern __shared__ __attribute__((aligned(16))) unsigned char lds[];
    Frame F;
    F.lds = (LAS unsigned char*)lds;
    F.MISC = (volatile LAS unsigned*)(F.lds + MISC_OFF);
    F.tid = threadIdx.x; F.lane = F.tid & 63; F.wave = __builtin_amdgcn_readfirstlane(F.tid >> 6);
    F.G = gridDim.x; const int bx = blockIdx.x; const int vcu = (F.G % 8 == 0) ? (bx % 8) * (F.G / 8) + bx / 8 : bx;
    F.gw = bx * NWAVES + F.wave; F.ngw = F.G * NWAVES;
    F.ws = args.ws; F.ctl = (gu32*)(args.ws + WS_CTL); F.out = args.out; F.dup = args.dup;
#pragma unroll
    for (int i = 0; i < 17; ++i) F.in[i] = args.in[i];
    for (int u = F.tid; u < (LDS_BYTES - LDSCTL_OFF) / 4; u += NWAVES * 64) ((LAS unsigned*)(F.lds + LDSCTL_OFF))[u] = 0u;
    __syncthreads();
    XcdBarrier bar = xcd_barrier_post((unsigned*)(F.ctl + CW_BAR), F.MISC + 8);
    const int lo = args.ph_lo, hi = args.ph_hi;
#define IN(k) (lo <= (k) && (k) < hi && ((MK_PHASE_MASK >> (k)) & 1))
#define SEAM(k) do { if ((k) + 1 < hi) xcd_barrier(bar); } while (0)

    if (lo <= 0 && 0 < hi) { if ((MK_PHASE_MASK >> 0) & 1) p0_prologue(F); SEAM(0); }
    if (lo <= 1 && 1 < hi) { if ((MK_PHASE_MASK >> 1) & 1) {
        if (bx < 112) meta_proj_task(F, bx);
        pg8::Gemm g{(const bf16*)(F.ws + WS_U), (const bf16*)(F.ws + WS_WIN), NTOK, NIN, DM};
        EpiProj E{(bf16*)(F.ws + WS_P), (const f32x2*)(F.ws + WS_TAB_RET), (const f32x2*)(F.ws + WS_TAB_DIFF)};
        { pg8::StaticOrder S; S.init(NTOK, NIN, F.G, bx); pg8::gemm_phase<EpiProj, pg8::StaticOrder, false>(F.lds, g, S, E); } }
        SEAM(1); }
    if (lo <= 2 && 2 < hi) { if ((MK_PHASE_MASK >> 2) & 1) { for (int u = vcu; u < 512; u += F.G) ret_kv_unit(F, u >> 7, (u >> 5) & 3, u & 31); }
        SEAM(2); }
    if (lo <= 3 && 3 < hi) { if ((MK_PHASE_MASK >> 3) & 1) ret_scan(F);
        SEAM(3); }
    if (lo <= 4 && 4 < hi) { if ((MK_PHASE_MASK >> 4) & 1) {
#if MK_GU_IN_P4
#define GU_SHARE() do { __syncthreads(); { const int a0_ = TR_I_IN + TR_I_OUT, tot_ = TR_ITEMS - a0_, t1_ = (tot_ * MK_W1 / 100) & ~7, t2_ = (tot_ * MK_W2 / 100) & ~7, \
        base_ = gslot == 1 ? a0_ : gslot == 2 ? a0_ + t1_ : a0_ + t1_ + t2_, tg_ = gslot == 1 ? t1_ : gslot == 2 ? t2_ : tot_ - t1_ - t2_, ng_ = (F.G - gslot + 2) / 3, \
        per_ = ((tg_ + ng_ - 1) / ng_ + 7) & ~7, lo_ = (vcu / 3) * per_, hi_ = lo_ + per_; \
        p0_weights(F, base_ + (lo_ < tg_ ? lo_ : tg_), base_ + (hi_ < tg_ ? hi_ : tg_), F.wave, NWAVES); } LDS_WAIT(); __syncthreads(); } while (0)
        const int gslot = vcu % 3;
        if (gslot == 1) GU_SHARE();
        for (int p2 = 2 * vcu; p2 < 512; p2 += 2 * F.G) {
#pragma nounroll
            for (int k = 0; k < 2; ++k) { const int bh = p2 >> 5, s = (p2 >> 1) & 15; diff_unit(F, bh >> 2, bh & 3, k ? s : 31 - s); if (k == 0 && gslot == 2) GU_SHARE(); } }
        for (int u = vcu; u < 512; u += F.G) ret_out_unit(F, u >> 7, (u >> 5) & 3, (u & 31) + 1);
        if (gslot == 0) GU_SHARE();
#undef GU_SHARE
#endif
        }
        SEAM(4); }
    if (lo <= 5 && 5 < hi) { if ((MK_PHASE_MASK >> 5) & 1) {
        pg8::Gemm g{(const bf16*)(F.ws + WS_MIXED), (const bf16*)(F.ws + WS_WOUT), NTOK, DM, DM}; pg8::StaticOrder S; S.init(NTOK, DM, F.G, bx);
        EpiH1 E{F.in[0], F.out, (float*)(F.ws + WS_SSP)};
        pg8::gemm_phase<EpiH1, pg8::StaticOrder, false>(F.lds, g, S, E); }
        SEAM(5); }
    if (lo <= 6 && 6 < hi) { if ((MK_PHASE_MASK >> 6) & 1) { for (int t = bx; t < NTOK / 64; t += F.G) router_task(F, t); }
        SEAM(6); }
    if (lo <= 7 && 7 < hi) { if ((MK_PHASE_MASK >> 7) & 1) {
        moe_tables(F, bx & 7);
        const LAS int* tb = (const LAS int*)(F.lds + MOE_TAB_OFF); const LAS int* cn = tb + 128; LAS unsigned* rowtab = (LAS unsigned*)(F.lds + MOE_ROWTAB_OFF);
        MoeSched S{tb, cn, rowtab, tb + 256, (const int*)(F.ws + WS_LIST), 4, bx & 7, bx >> 3, F.G >> 3};
        { pg8::Unit u; const int* list = (const int*)(F.ws + WS_LIST);
          for (int i = 0; i < 7 && S.next(i, u); ++i) if (F.tid < 256) { const int e = u.pn >> 2, r = (u.pm - tb[e]) * 256 + F.tid;
              const int tok = list[(size_t)e * NTOK + (r < cn[e] ? r : 0)]; rowtab[i * 256 + F.tid] = (unsigned)tok * (unsigned)(DM * 2); }
          __syncthreads(); }
        pg8::Gemm g{(const bf16*)(F.ws + WS_U), (const bf16*)(F.ws + WS_WGU), MAXSLOT, NEXP * 1024, DM};
        EpiAct E{(bf16*)(F.ws + WS_HACT)};
        pg8::gemm_phase<EpiAct, MoeSched, true, false>(F.lds, g, S, E);
#if MK_LATE_WD
        if (!F.dup) for (;;) {
            __syncthreads();
            if (F.tid == 0) F.MISC[12] = __hip_atomic_fetch_add(F.ctl + CW_Q, 1u, RLX_AGENT);
            __syncthreads();
            const int grab = (int)F.MISC[12];
            if (grab * 64 >= TR_I_D) break;
            p0_weights(F, TR_ITEMS - TR_I_D + grab * 64, TR_ITEMS - TR_I_D + grab * 64 + 64, F.wave, NWAVES);
        }
#endif
        }
        SEAM(7); }
    if (lo <= 8 && 8 < hi) { if ((MK_PHASE_MASK >> 8) & 1) {
        moe_tables(F, bx & 7);
        const LAS int* tb = (const LAS int*)(F.lds + MOE_TAB_OFF); const LAS int* cn = tb + 128;
        MoeSched S{tb, cn, nullptr, tb + 256, nullptr, 8, bx & 7, bx >> 3, F.G >> 3};
        pg8::Gemm g{(const bf16*)(F.ws + WS_HACT), (const bf16*)(F.ws + WS_WD), MAXSLOT, NEXP * DM, FF};
        EpiY E{(bf16*)(F.ws + WS_Y), (const float*)(F.ws + WS_WL), tb, cn};
        pg8::gemm_phase<EpiY, MoeSched, false, false>(F.lds, g, S, E); }
        SEAM(8); }
    if (lo <= 9 && 9 < hi) { if ((MK_PHASE_MASK >> 9) & 1) {
        moe_tables(F, bx & 7);
        const LAS int* tb = (const LAS int*)(F.lds + MOE_TAB_OFF);
        for (int t = F.gw; t < NTOK; t += F.ngw) final_row<(MK_BRINGUP >= 3)>(F, t, tb); } }
#undef IN
#undef SEAM
}

extern "C" void kernel_launch(void* const* d_in, const int* in_sizes, int n_in, void* d_out, int out_size, void* d_ws, size_t ws_size, hipStream_t stream) {
    static int grid = 0;
    if (grid == 0) {
        if (n_in != 17 || out_size != NTOK * DM || ws_size < WS_END) { fprintf(stderr, "kernel_launch: unexpected shapes (n_in %d out %d ws %zu, need ws >= %zu); nothing launched\n", n_in, out_size, ws_size, (size_t)WS_END); grid = -1; return; }
        int dev = 0, cus = 0, per_cu = 0;
        if (hipGetDevice(&dev) != hipSuccess || hipDeviceGetAttribute(&cus, hipDeviceAttributeMultiprocessorCount, dev) != hipSuccess) { grid = -1; return; }
        if (hipFuncSetAttribute((const void*)mk_fwd, hipFuncAttributeMaxDynamicSharedMemorySize, LDS_BYTES) != hipSuccess) { fprintf(stderr, "kernel_launch: hipFuncSetAttribute failed\n"); grid = -1; return; }
        if (hipOccupancyMaxActiveBlocksPerMultiprocessor(&per_cu, (const void*)mk_fwd, NWAVES * 64, LDS_BYTES) != hipSuccess || per_cu < 1) fprintf(stderr, "kernel_launch: occupancy query reports %d blocks per CU\n", per_cu);
        (void)hipGetLastError();
        grid = cus - (cus & 7);
    }
    if (grid < 0) return;
    if (hipMemsetAsync((char*)d_ws + WS_CTL, 0, CTL_ZERO_BYTES, stream) != hipSuccess) return;
    Args a{};
    for (int i = 0; i < 17; ++i) a.in[i] = (const float*)d_in[i];
    a.out = (float*)d_out; a.ws = (unsigned char*)d_ws;
    if (MK_N_LAUNCHES == 1) { a.ph_lo = 0; a.ph_hi = N_PHASES; hipLaunchKernelGGL(mk_fwd, dim3(grid), dim3(NWAVES * 64), LDS_BYTES, stream, a); }
    else for (int p = 0; p < N_PHASES; ++p) for (int rep = 0; rep < (((MK_DUP_MASK >> p) & 1) ? 2 : 1); ++rep) { a.ph_lo = p; a.ph_hi = p + 1; a.dup = (((MK_DUP_MASK >> p) & 1) && rep == 0 && (p == 5 || p == 6 || p == 9)) ? 1 : 0; hipLaunchKernelGGL(mk_fwd, dim3(grid), dim3(NWAVES * 64), LDS_BYTES, stream, a); }
}
```

```cpp
#include <hip/hip_runtime.h>
#include <cstdio>
#include <cstdint>
#include <cmath>
namespace pg8 {
#define PG8_LAS __attribute__((address_space(3)))
typedef unsigned short bf16_t;
typedef short bf16x8 __attribute__((ext_vector_type(8)));
typedef float f32x4 __attribute__((ext_vector_type(4)));
typedef unsigned u32x4 __attribute__((ext_vector_type(4)));
constexpr int BM = 256, BK = 64, HALF = 128, HTB = HALF * BK * 2  , STAGE_BYTES = 8 * HTB, NXCD = 8, WGM = 4;

__host__ __device__ __forceinline__ int lds_byte(int r, int c) { const int st = (r >> 4) * 2 + (c >> 5), rr = r & 15, cc = c & 31, ob = rr * 64 + cc * 2; return st * 1024 + (ob ^ (((ob >> 9) & 1) << 5)); }
__host__ __device__ __forceinline__ void stage_rc(int b, int& R, int& C) { const int st = b / 1024, sb = b % 1024, swz = sb ^ (((sb >> 9) & 1) << 5); R = (st >> 1) * 16 + swz / 64; C = (st & 1) * 32 + (swz % 64) / 2; }
__host__ __device__ __forceinline__ int perm32(int rho) { const int n = rho >> 4, i = rho & 15; return 8 * (i >> 2) + 4 * n + (i & 3); }

struct Unit { int pm, pn, aux; };
struct Gemm { const bf16_t* A; const bf16_t* Bt; int M, N, K; };

struct StaticOrder {
    int nM, nN, nwg, G, c;
    __host__ __device__ void init(int M, int N, int G_, int c_) { nM = M / BM; nN = N / BM; nwg = nM * nN; G = G_; c = c_; }
    __host__ __device__ bool next(int i, Unit& u) const {
        const long L = (long)i * G + c; if (L >= nwg) return false;
        int wgid = (int)L; { const int q = nwg / NXCD, r = nwg % NXCD, xcd = wgid % NXCD, off = wgid / NXCD; wgid = (xcd < r ? xcd * (q + 1) : r * (q + 1) + (xcd - r) * q) + off; }
        const int nig = WGM * nN, gid = wgid / nig, fm = gid * WGM, gsz = (nM - fm) < WGM ? (nM - fm) : WGM;
        u.pm = fm + ((wgid % nig) % gsz); u.pn = (wgid % nig) / gsz; return true;
    }
    __device__ __forceinline__ unsigned rowoff(const Unit&, int) const { return 0u; }
};

__device__ __forceinline__ unsigned cvt_pk_bf16(float lo, float hi) { unsigned r; asm volatile("v_cvt_pk_bf16_f32 %0, %1, %2" : "=v"(r) : "v"(lo), "v"(hi)); return r; }

template <class Epi, class Sched, bool GATHER, bool HALFSKIP = false>
__device__ __forceinline__ void gemm_phase(PG8_LAS unsigned char* lds, const Gemm g, const Sched& S, const Epi& E) {
    const int tid = threadIdx.x, wid = __builtin_amdgcn_readfirstlane(tid >> 6), lane = tid & 63, wr = wid >> 2, wc = wid & 3, fr = lane & 15, fq = lane >> 4;
    const int K = g.K, nt = K / BK;
    unsigned voffA[2], voffB[2]; int RA[2], CA[2];
#pragma unroll
    for (int i = 0; i < 2; ++i) { int R, C; stage_rc(tid * 16 + i * 8192, R, C); const int Rb = Epi::PERM ? ((R & ~31) + perm32(R & 31)) : R;
        RA[i] = R; CA[i] = C; voffA[i] = (unsigned)(R * K + C) * 2u; voffB[i] = (unsigned)(Rb * K + C) * 2u; }
    const size_t kstep = (size_t)(BK * 2);
    const size_t hstep = (size_t)HALF * K * 2;
    const size_t tstep = 2 * hstep;
    const unsigned ldsw = (unsigned)wid * 1024u;
    const int aoff = lds_byte(wr * 64 + fr, fq * 8), boff = lds_byte(wc * 32 + fr, fq * 8);
#define PG8_SA(b, h) (((b) * 2 + (h)) * HTB)
#define PG8_SB(b, h) ((4 + (b) * 2 + (h)) * HTB)
#define PG8_STAGE(bufoff, gbase, voff) do { _Pragma("unroll") for (int _i = 0; _i < 2; ++_i) \
        __builtin_amdgcn_global_load_lds((const unsigned*)((const char*)(gbase) + (voff)[_i]), (PG8_LAS unsigned*)(lds + (bufoff) + ldsw + _i * 8192), 16, 0, 0); } while (0)
#define PG8_STAGE_A(bufoff, gb, h, nx) do { if constexpr (GATHER) { _Pragma("unroll") for (int _i = 0; _i < 2; ++_i) \
        __builtin_amdgcn_global_load_lds((const unsigned*)((const char*)(gb) + ((nx) ? vGn[h][_i] : vGc[h][_i])), (PG8_LAS unsigned*)(lds + (bufoff) + ldsw + _i * 8192), 16, 0, 0); } \
        else { PG8_STAGE(bufoff, (gb) + (h) * hstep, voffA); } } while (0)
#define PG8_LDA(dst, b, h) do { _Pragma("unroll") for (int m = 0; m < 4; ++m) _Pragma("unroll") for (int k = 0; k < 2; ++k) dst[m][k] = *(const PG8_LAS bf16x8*)(lds + PG8_SA(b, h) + aoff + m * 2048 + k * 1024); } while (0)
#define PG8_LDB(dst, b, h) do { _Pragma("unroll") for (int n = 0; n < 2; ++n) _Pragma("unroll") for (int k = 0; k < 2; ++k) dst[n][k] = *(const PG8_LAS bf16x8*)(lds + PG8_SB(b, h) + boff + n * 2048 + k * 1024); } while (0)
#define PG8_MMA(ai, bj, At, Bt) do { __builtin_amdgcn_s_setprio(1); _Pragma("unroll") for (int m = 0; m < 4; ++m) _Pragma("unroll") for (int n = 0; n < 2; ++n) _Pragma("unroll") for (int k = 0; k < 2; ++k) \
        acc[ai][bj][m][n] = __builtin_amdgcn_mfma_f32_16x16x32_bf16(Bt[n][k], At[m][k], acc[ai][bj][m][n], 0, 0, 0); __builtin_amdgcn_s_setprio(0); } while (0)
#define PG8_WAIT_V(n) asm volatile("s_waitcnt vmcnt(" #n ")" ::: "memory")
#define PG8_WAIT_L(n) asm volatile("s_waitcnt lgkmcnt(" #n ")" ::: "memory")
#define PG8_BAR __builtin_amdgcn_s_barrier()
#define PG8_SCHED __builtin_amdgcn_sched_barrier(0)
    Unit cur, nxt; int ui = 0;
    if (!S.next(0, cur)) return;
    f32x4 acc[2][2][4][2];
#pragma unroll
    for (int a = 0; a < 2; ++a)
#pragma unroll
        for (int b = 0; b < 2; ++b)
#pragma unroll
            for (int m = 0; m < 4; ++m)
#pragma unroll
                for (int n = 0; n < 2; ++n) acc[a][b][m][n] = (f32x4){0.f, 0.f, 0.f, 0.f};
    bf16x8 At[4][2], B0[2][2], B1[2][2];
    unsigned vGc[2][2] = {{0u, 0u}, {0u, 0u}}, vGn[2][2] = {{0u, 0u}, {0u, 0u}};
    if constexpr (GATHER) {
#pragma unroll
        for (int h = 0; h < 2; ++h)
#pragma unroll
            for (int i = 0; i < 2; ++i) { vGc[h][i] = S.rowoff(cur, h * HALF + RA[i]) + (unsigned)CA[i] * 2u; vGn[h][i] = vGc[h][i]; }
    }
    const char* cA = GATHER ? (const char*)g.A : (const char*)g.A + (size_t)cur.pm * tstep; const char* cB = (const char*)g.Bt + (size_t)cur.pn * tstep;
    PG8_STAGE(PG8_SB(0, 0), cB, voffB); PG8_STAGE(PG8_SB(0, 1), cB + hstep, voffB); PG8_STAGE_A(PG8_SA(0, 0), cA, 0, false); PG8_STAGE_A(PG8_SA(0, 1), cA, 1, false);
    if (wr == 1) PG8_BAR;
    PG8_WAIT_V(2); PG8_BAR;
    PG8_STAGE(PG8_SB(1, 0), cB + kstep, voffB); PG8_STAGE_A(PG8_SA(1, 0), cA + kstep, 0, false); PG8_STAGE(PG8_SB(1, 1), cB + hstep + kstep, voffB);
    PG8_WAIT_V(6); PG8_BAR;
    for (;;) {
        const bool has_next = S.next(ui + 1, nxt);
        const bool chalf = HALFSKIP && ((cur.aux >> 16) & 1);
        if constexpr (GATHER) { if (has_next) {
#pragma unroll
            for (int h = 0; h < 2; ++h)
#pragma unroll
                for (int i = 0; i < 2; ++i) vGn[h][i] = S.rowoff(nxt, h * HALF + RA[i]) + (unsigned)CA[i] * 2u; } }
        const char* nA = GATHER ? cA : (has_next ? (const char*)g.A + (size_t)nxt.pm * tstep : cA); const char* nB = has_next ? (const char*)g.Bt + (size_t)nxt.pn * tstep : cB;
        for (int t = 0; t < nt; t += 2) {
            const bool last = (t == nt - 2);
            const char* a1 = cA + (size_t)(t + 1) * kstep;
            const char* a2 = last ? nA : cA + (size_t)(t + 2) * kstep; const char* b2 = last ? nB : cB + (size_t)(t + 2) * kstep;
            const char* a3 = a2 + kstep; const char* b3 = b2 + kstep;
            PG8_LDB(B0, 0, 0); PG8_LDB(B1, 0, 1); PG8_SCHED; PG8_LDA(At, 0, 0); PG8_STAGE_A(PG8_SA(1, 1), a1, 1, false);
            PG8_WAIT_V(8); PG8_WAIT_L(0); PG8_BAR; PG8_MMA(0, 0, At, B0); PG8_MMA(0, 1, At, B1); PG8_BAR; PG8_SCHED;
            PG8_LDA(At, 0, 1); PG8_STAGE(PG8_SB(0, 0), b2, voffB); PG8_STAGE(PG8_SB(0, 1), b2 + hstep, voffB); PG8_STAGE_A(PG8_SA(0, 0), a2, 0, last);
            PG8_WAIT_V(8); PG8_WAIT_L(0); PG8_BAR; if (!HALFSKIP || !chalf) { PG8_MMA(1, 0, At, B0); PG8_MMA(1, 1, At, B1); } PG8_BAR; PG8_SCHED;
            PG8_LDB(B0, 1, 0); PG8_LDB(B1, 1, 1); PG8_SCHED; PG8_LDA(At, 1, 0); PG8_STAGE_A(PG8_SA(0, 1), a2, 1, last);
            PG8_WAIT_V(8); PG8_WAIT_L(0); PG8_BAR; PG8_MMA(0, 0, At, B0); PG8_MMA(0, 1, At, B1); PG8_BAR; PG8_SCHED;
            PG8_LDA(At, 1, 1); PG8_STAGE(PG8_SB(1, 0), b3, voffB); PG8_STAGE(PG8_SB(1, 1), b3 + hstep, voffB); PG8_STAGE_A(PG8_SA(1, 0), a3, 0, last);
            PG8_WAIT_V(8); PG8_WAIT_L(0); PG8_BAR; if (!HALFSKIP || !chalf) { PG8_MMA(1, 0, At, B0); PG8_MMA(1, 1, At, B1); } PG8_BAR; PG8_SCHED;
        }
        if (wr == 0) PG8_BAR;
        E(acc, cur, wr, wc, fr, fq);
        if (!has_next) break;
#pragma unroll
        for (int a = 0; a < 2; ++a)
#pragma unroll
            for (int b = 0; b < 2; ++b)
#pragma unroll
                for (int m = 0; m < 4; ++m)
#pragma unroll
                    for (int n = 0; n < 2; ++n) acc[a][b][m][n] = (f32x4){0.f, 0.f, 0.f, 0.f};
        cur = nxt; cA = nA; cB = nB; ++ui;
        if constexpr (GATHER) {
#pragma unroll
            for (int h = 0; h < 2; ++h)
#pragma unroll
                for (int i = 0; i < 2; ++i) vGc[h][i] = vGn[h][i]; }
        if (wr == 1) PG8_BAR;
    }
    PG8_WAIT_V(0);
    PG8_BAR;
#undef PG8_SA
#undef PG8_SB
#undef PG8_STAGE
#undef PG8_STAGE_A
#undef PG8_LDA
#undef PG8_LDB
#undef PG8_MMA
#undef PG8_WAIT_V
#undef PG8_WAIT_L
#undef PG8_BAR
#undef PG8_SCHED
}
}
#define GAS __attribute__((address_space(1)))
#define LAS __attribute__((address_space(3)))
typedef unsigned short bf16;
typedef unsigned v4u __attribute__((ext_vector_type(4)));
typedef float f32x4 __attribute__((ext_vector_type(4)));
typedef short bf16x8 __attribute__((ext_vector_type(8)));
typedef GAS unsigned gu32;
typedef GAS unsigned long long gu64;
#define RLX_AGENT __ATOMIC_RELAXED, __HIP_MEMORY_SCOPE_AGENT
#define LDS_WAIT() asm volatile("s_waitcnt lgkmcnt(0)" ::: "memory")
#define VM_WAIT() asm volatile("s_waitcnt vmcnt(0)" ::: "memory")
__device__ __forceinline__ unsigned long long rt() { return __builtin_amdgcn_s_memrealtime(); }
__device__ __forceinline__ unsigned f2bf(float f) { unsigned u = __builtin_bit_cast(unsigned, f); return (u + 0x7fffu + ((u >> 16) & 1u)) >> 16; }
__device__ __forceinline__ unsigned pk2(float lo, float hi) { return f2bf(lo) | (f2bf(hi) << 16); }
#define XB_TMO      128
#define XB_XCNT(j)  (256  + 64 * (j))
#define XB_XSUB(j)  (1280 + 64 * (j))
#define XB_XGEN(j)  (2304 + 64 * (j))
#define XB_TOP      3328
#define XB_TOPGEN   3392
#define XCD_BAR_WORDS 3456
#define XB_SPIN_CAP (1u << 18)

__device__ __forceinline__ unsigned xb_ld(unsigned* p)              { return __hip_atomic_load(p, __ATOMIC_RELAXED, __HIP_MEMORY_SCOPE_AGENT); }
__device__ __forceinline__ unsigned xb_add(unsigned* p, unsigned v) { return __hip_atomic_fetch_add(p, v, __ATOMIC_RELAXED, __HIP_MEMORY_SCOPE_AGENT); }
__device__ __forceinline__ unsigned xb_xcc_id() { return (unsigned)__builtin_amdgcn_s_getreg((3 << 11) | 20) & 0xFu; }
#define XB_SPIN(cond, bar) do { unsigned _sp = 0; while (cond) { __builtin_amdgcn_s_sleep(1); \
    if ((++_sp & 255u) == 0u) { if (xb_ld(&(bar)[XB_TMO])) break; if (_sp > XB_SPIN_CAP) { atomicAdd(&(bar)[XB_TMO], 1u); break; } } } } while (0)

struct XcdBarrier {
    unsigned* bar; unsigned x;
    volatile LAS unsigned* st;
};

__device__ __forceinline__ XcdBarrier xcd_barrier_post(unsigned* bar, volatile LAS unsigned* st) {
    XcdBarrier b; b.bar = bar; b.x = xb_xcc_id(); b.st = st;
    if (threadIdx.x == 0) (void)xb_add(&bar[XB_XCNT(b.x)], 1u);
    return b;
}
__device__ __forceinline__ void xcd_barrier_complete(unsigned* bar, unsigned x, unsigned& nloc, unsigned& nx) {
    const unsigned G = gridDim.x * gridDim.y * gridDim.z;
    unsigned sum, cnt, mine, sp = 0u;
    for (;;) {
        sum = 0u; cnt = 0u; mine = 0u;
#pragma unroll
        for (unsigned j = 0; j < 16; ++j) { const unsigned c = xb_ld(&bar[XB_XCNT(j)]); sum += c; cnt += (c > 0u) ? 1u : 0u; mine = (j == x) ? c : mine; }
        if (sum == G) break;
        __builtin_amdgcn_s_sleep(1);
        if ((++sp & 255u) == 0u) { if (xb_ld(&bar[XB_TMO])) break; if (sp > XB_SPIN_CAP) { atomicAdd(&bar[XB_TMO], 1u); break; } }
    }
    nloc = mine > 0u ? mine : 1u; nx = cnt > 0u ? cnt : 1u;
}

__device__ __forceinline__ void xcd_barrier(const XcdBarrier& b) {
    asm volatile("s_waitcnt vmcnt(0)" ::: "memory");
    __syncthreads();
    if (threadIdx.x == 0) {
        unsigned* bar = b.bar;
        __builtin_amdgcn_s_waitcnt(0);
        unsigned nloc = b.st[0], nx = b.st[1];
        if (nloc == 0u) { xcd_barrier_complete(bar, b.x, nloc, nx); b.st[0] = nloc; b.st[1] = nx; }
        const unsigned old = xb_add(&bar[XB_XSUB(b.x)], 1u);
        const unsigned gen = old / nloc;
        if (old + 1u == (gen + 1u) * nloc) {
            __builtin_amdgcn_fence(__ATOMIC_RELEASE, "agent");
            asm volatile("s_waitcnt vmcnt(0)" ::: "memory");
            const unsigned og = xb_add(&bar[XB_TOP], 1u);
            const unsigned tg = og / nx;
            if (og + 1u == (tg + 1u) * nx) xb_add(&bar[XB_TOPGEN], 1u);
            else XB_SPIN(xb_ld(&bar[XB_TOPGEN]) == tg, bar);
            __builtin_amdgcn_fence(__ATOMIC_ACQUIRE, "agent");
            xb_add(&bar[XB_XGEN(b.x)], 1u);
            asm volatile("s_waitcnt vmcnt(0)" ::: "memory");
        } else {
            XB_SPIN(xb_ld(&bar[XB_XGEN(b.x)]) == gen, bar);
            __builtin_amdgcn_fence(__ATOMIC_ACQUIRE, "agent");
            asm volatile("s_waitcnt vmcnt(0)" ::: "memory");
        }
    }
    __syncthreads();
}
#ifndef MK_LATE_WD
#define MK_LATE_WD 0
#endif
#ifndef MK_GU_FIRST_PCT
#define MK_GU_FIRST_PCT 54
#endif
#ifndef MK_GU_IN_P4
#define MK_GU_IN_P4 1
#endif
constexpr int NWAVES = 8;
constexpr int DM = 2048, NB = 4, SEQ = 4096, NTOK = NB * SEQ;
constexpr int LPAD = 4224, LROWS = NB * LPAD;
constexpr int NIN = 6144;
constexpr int C_RQ = 0, C_RK = 512, C_RV = 1024, C_RG = 2048, C_DQ = 3072, C_DK = 4096, C_DV = 5120;
constexpr int NEXP = 64, FF = 512, NPOS = 4112;
constexpr float EPS = 1e-6f;
constexpr float QK_SCALE = 0.08838834764831845f;
constexpr float LOG2E = 1.4426950408889634f;
constexpr float LAMBDA_INIT = 0.2f;
constexpr int MAXSLOT = 49152;

constexpr size_t MiB = 1u << 20;
constexpr size_t WS_CTL = 0, CTL_ZERO_BYTES = 65536;
constexpr size_t WS_TAB_RET = 1 * MiB;
constexpr size_t WS_TAB_DIFF = 4 * MiB;
constexpr size_t WS_MISC = 5 * MiB;
constexpr size_t WS_WR = 6 * MiB;
constexpr size_t WS_LIST = 8 * MiB, WS_WL = 12 * MiB, WS_TOKSLOT = 16 * MiB, WS_SSP = 17 * MiB;
constexpr size_t WS_WIN = 20 * MiB, WS_WOUT = 44 * MiB, WS_WGU = 52 * MiB, WS_WD = 308 * MiB;
constexpr size_t WS_U = 436 * MiB, WS_MIXED = 500 * MiB, WS_P = 564 * MiB, WS_KV = 762 * MiB, WS_S = 826 * MiB, WS_END = 858 * MiB;
constexpr size_t WS_Y = WS_P, WS_HACT = WS_KV;
static_assert(WS_P + (size_t)LROWS * NIN * 2 <= WS_KV && WS_Y + (size_t)MAXSLOT * DM * 2 <= WS_KV && WS_HACT + (size_t)MAXSLOT * FF * 2 <= WS_S, "ws map");
constexpr int CW_TMO = 0, CW_CODE = 1, CW_Q = 64  , CW_SPLIT = 192  , CW_BAR = 4096, CW_CNT = 8192  , CW_SS = 16384  ;
static_assert((CW_CNT + 64 * 64 + 64) * 4 <= (int)CTL_ZERO_BYTES && (CW_BAR + XCD_BAR_WORDS) <= CW_CNT && CW_SPLIT + 64 <= CW_BAR, "ctl");

constexpr int RING_BYTES = 131072;
constexpr int MOE_TAB_OFF = RING_BYTES;
constexpr int MOE_ROWTAB_OFF = MOE_TAB_OFF + 2048;
constexpr int LDSCTL_OFF = MOE_ROWTAB_OFF + 7 * 1024, MISC_OFF = LDSCTL_OFF + 320;
constexpr int LDS_BYTES = 147456;
static_assert(MISC_OFF + 128 <= LDS_BYTES, "LDS map");

typedef unsigned u32x4 __attribute__((ext_vector_type(4)));
typedef unsigned u32x2 __attribute__((ext_vector_type(2)));
typedef float f32x2 __attribute__((ext_vector_type(2)));
typedef short s16x4 __attribute__((ext_vector_type(4)));

__device__ __forceinline__ unsigned cvtpk(float lo, float hi) { return pg8::cvt_pk_bf16(lo, hi); }
__device__ __forceinline__ float bf_lo(unsigned w) { return __uint_as_float(w << 16); }
__device__ __forceinline__ float bf_hi(unsigned w) { return __uint_as_float(w & 0xffff0000u); }
__device__ __forceinline__ float wave_sum(float v) {
#pragma unroll
    for (int o = 1; o < 64; o <<= 1) v += __shfl_xor(v, o);
    return v;
}
__device__ __forceinline__ float xmax16(float v) { auto r = __builtin_amdgcn_permlane16_swap(__float_as_uint(v), __float_as_uint(v), false, false); return fmaxf(__uint_as_float(r[0]), __uint_as_float(r[1])); }
__device__ __forceinline__ float xmax32(float v) { auto r = __builtin_amdgcn_permlane32_swap(__float_as_uint(v), __float_as_uint(v), false, false); return fmaxf(__uint_as_float(r[0]), __uint_as_float(r[1])); }
__device__ __forceinline__ float xsum16(float v) { auto r = __builtin_amdgcn_permlane16_swap(__float_as_uint(v), __float_as_uint(v), false, false); return __uint_as_float(r[0]) + __uint_as_float(r[1]); }
__device__ __forceinline__ float xsum32(float v) { auto r = __builtin_amdgcn_permlane32_swap(__float_as_uint(v), __float_as_uint(v), false, false); return __uint_as_float(r[0]) + __uint_as_float(r[1]); }

struct Frame {
    LAS unsigned char* lds;
    volatile LAS unsigned* MISC;
    gu32* ctl;
    int tid, lane, wave, G, gw, ngw;
    unsigned char* ws;
    const float* in[17];
    float* out;
    int dup;
};
__device__ __forceinline__ void sincos_d(double a, float& s, float& c) {
    const double k = __builtin_rint(a * 0.63661977236758134308);
    double r = __builtin_fma(-k, 1.57079632679489655800e+00, a);
    r = __builtin_fma(-k, 6.12323399573676603587e-17, r);
    const double r2 = r * r;
    double sp = 1.0 / 6227020800.0; sp = __builtin_fma(sp, r2, -1.0 / 39916800.0); sp = __builtin_fma(sp, r2, 1.0 / 362880.0); sp = __builtin_fma(sp, r2, -1.0 / 5040.0);
    sp = __builtin_fma(sp, r2, 1.0 / 120.0); sp = __builtin_fma(sp, r2, -1.0 / 6.0); sp = __builtin_fma(sp * r2, r, r);
    double cp = -1.0 / 87178291200.0; cp = __builtin_fma(cp, r2, 1.0 / 479001600.0); cp = __builtin_fma(cp, r2, -1.0 / 3628800.0); cp = __builtin_fma(cp, r2, 1.0 / 40320.0);
    cp = __builtin_fma(cp, r2, -1.0 / 720.0); cp = __builtin_fma(cp, r2, 1.0 / 24.0); cp = __builtin_fma(cp, r2, -0.5); cp = __builtin_fma(cp, r2, 1.0);
    const int q = ((int)k) & 3;
    const double sv = (q == 0) ? sp : (q == 1) ? cp : (q == 2) ? -sp : -cp;
    const double cv = (q == 0) ? cp : (q == 1) ? -sp : (q == 2) ? -cp : sp;
    s = (float)sv; c = (float)cv;
}
__host__ __device__ __forceinline__ int win_dest(int n) {
    if (n < 1024) { const int tile = n >> 8, head2 = (n >> 7) & 1, d = n & 127; return tile * 256 + (d < 64 ? head2 * 64 + d : 128 + head2 * 64 + (d - 64)); }
    if (n >= C_DQ && n < C_DV) { const int tile = n >> 8, comp = (n >> 7) & 1, d = n & 127;
        return tile * 256 + (d < 16 ? comp * 16 + d : d < 32 ? 128 + comp * 16 + (d - 16) : comp * 128 + d); }
    return n;
}
struct TrItem { const float* src; bf16* dst; int N, K, mode, n0; };
constexpr int TR_I_IN = 32 * 96, TR_I_OUT = 32 * 32, TR_I_G = 64 * 256, TR_I_D = 64 * 256, TR_ITEMS = TR_I_IN + TR_I_OUT + 2 * TR_I_G + TR_I_D;
__device__ __forceinline__ TrItem tr_desc(Frame& F, int it) {
    TrItem d; int r = it;
    if (r < TR_I_IN) { const int kb = r / 96, nb = r % 96; d.N = NIN; d.K = DM; d.mode = 1; d.n0 = nb * 64; d.src = F.in[3] + (size_t)(kb * 64) * NIN + nb * 64; d.dst = (bf16*)(F.ws + WS_WIN) + kb * 64; return d; } r -= TR_I_IN;
    if (r < TR_I_OUT) { const int kb = r >> 5, nb = r & 31; d.N = DM; d.K = DM; d.mode = 0; d.n0 = nb * 64; d.src = F.in[4] + (size_t)(kb * 64) * DM + nb * 64; d.dst = (bf16*)(F.ws + WS_WOUT) + kb * 64; return d; } r -= TR_I_OUT;
    if (r < 2 * TR_I_G) { const int up = r >= TR_I_G; if (up) r -= TR_I_G; const int e = r >> 8, q = r & 255, kb = q >> 3, nb = q & 7; d.N = FF; d.K = DM; d.mode = 2 + up; d.n0 = nb * 64;
        d.src = F.in[13 + up] + (size_t)e * DM * FF + (size_t)(kb * 64) * FF + nb * 64; d.dst = (bf16*)(F.ws + WS_WGU) + (size_t)e * 1024 * DM + kb * 64; return d; } r -= 2 * TR_I_G;
    { const int e = r >> 8, q = r & 255, kb = q >> 5, nb = q & 31; d.N = DM; d.K = FF; d.mode = 0; d.n0 = nb * 64; d.src = F.in[15] + (size_t)e * FF * DM + (size_t)(kb * 64) * DM + nb * 64; d.dst = (bf16*)(F.ws + WS_WD) + (size_t)e * DM * FF + kb * 64; return d; }
}
__device__ __forceinline__ int tr_dest(int mode, int n) { return mode == 0 ? n : mode == 1 ? win_dest(n) : mode == 2 ? ((n >> 7) * 256 + (n & 127)) : ((n >> 7) * 256 + 128 + (n & 127)); }
#define TR_ISSUE(v, d) do { const float* s_ = (d).src + (size_t)(lane >> 4) * (d).N + 4 * (lane & 15); _Pragma("unroll") for (int i_ = 0; i_ < 16; ++i_) v[i_] = __builtin_nontemporal_load((const f32x4*)(s_ + (size_t)(4 * i_) * (d).N)); } while (0)
#define TR_PROCESS(v, d) do { \
        _Pragma("unroll") for (int i_ = 0; i_ < 16; ++i_) { LAS float* w_ = scr + (4 * i_ + (lane >> 4)) * 65 + 4 * (lane & 15); w_[0] = v[i_][0]; w_[1] = v[i_][1]; w_[2] = v[i_][2]; w_[3] = v[i_][3]; } \
        LDS_WAIT(); \
        _Pragma("unroll") for (int p_ = 0; p_ < 8; ++p_) { const int n_ = 8 * p_ + (lane >> 3); const LAS float* r_ = scr + (8 * (lane & 7)) * 65 + n_; \
            u32x4 o_; o_.x = cvtpk(r_[0], r_[65]); o_.y = cvtpk(r_[130], r_[195]); o_.z = cvtpk(r_[260], r_[325]); o_.w = cvtpk(r_[390], r_[455]); \
            u32x4* q_ = (u32x4*)((d).dst + (size_t)tr_dest((d).mode, (d).n0 + n_) * (d).K + 8 * (lane & 7)); if (NTST) __builtin_nontemporal_store(o_, q_); else *q_ = o_; } \
        LDS_WAIT(); } while (0)
template <bool NTST = true>
__device__ __forceinline__ void p0_weights(Frame& F, int first, int last, int wr, int nw) {
    int lane = F.lane; asm volatile("" : "+v"(lane));
    int wofs = F.wave * 16640; asm volatile("" : "+s"(wofs));
    LAS float* scr = (LAS float*)(F.lds + wofs);
    f32x4 va[16], vb[16];
    int it = first + wr; if (it >= last) return;
    TrItem da = tr_desc(F, it), db = da; TR_ISSUE(va, da);
    for (;;) {
        const int itb = it + nw; const bool hb = itb < last; if (hb) { db = tr_desc(F, itb); TR_ISSUE(vb, db); }
        TR_PROCESS(va, da);
        if (!hb) break;
        it = itb + nw; const bool ha = it < last; if (ha) { da = tr_desc(F, it); TR_ISSUE(va, da); }
        TR_PROCESS(vb, db);
        if (!ha) break;
    }
}
__device__ __forceinline__ void rms_row_to_bf16(const float* __restrict__ xrow, const float* __restrict__ g, bf16* __restrict__ orow, int lane) {
    const f32x4* xr = (const f32x4*)xrow + lane; f32x4 v[8]; float s = 0.f;
#pragma unroll
    for (int j = 0; j < 8; ++j) { v[j] = __builtin_nontemporal_load(xr + 64 * j); s += (v[j].x * v[j].x + v[j].y * v[j].y) + (v[j].z * v[j].z + v[j].w * v[j].w); }
    const float r = 1.0f / sqrtf(wave_sum(s) * (1.f / DM) + EPS);
    u32x2* o8 = (u32x2*)orow + lane;
#pragma unroll
    for (int j = 0; j < 8; ++j) { const f32x4 gg = ((const f32x4*)g)[lane + 64 * j]; u32x2 w; w.x = cvtpk(v[j].x * r * gg.x, v[j].y * r * gg.y); w.y = cvtpk(v[j].z * r * gg.z, v[j].w * r * gg.w); o8[64 * j] = w; }
}
__device__ __forceinline__ void p0_prologue(Frame& F) {
    unsigned char* ws = F.ws;
    const int gt = F.gw * 64 + F.lane, ngt = F.ngw * 64;
    { f32x2* tr = (f32x2*)(ws + WS_TAB_RET); f32x2* td = (f32x2*)(ws + WS_TAB_DIFF);
      for (int e = gt; e < NPOS * 80; e += ngt) { const int pos = e / 80, i = e - pos * 80;
        float inv; if (i < 64) inv = 1.0f / __builtin_amdgcn_exp2f((float)i * (13.287712379549449f / 63.0f)); else inv = __builtin_amdgcn_exp2f(-(float)(i - 64) * (18.931568569324174f / 16.0f));
        const float ang = (float)pos * inv; float s, c; sincos_d((double)ang, s, c);
        if (i < 64) tr[pos * 64 + i] = (f32x2){c, s}; else td[pos * 16 + (i - 64)] = (f32x2){c, s}; } }
    if (gt == 0) { float a = 0.f, b = 0.f; for (int i = 0; i < 128; ++i) { a += F.in[5][i] * F.in[6][i]; b += F.in[7][i] * F.in[8][i]; }
        *(float*)(ws + WS_MISC) = expf(a) - expf(b) + LAMBDA_INIT; }
    { bf16* wr = (bf16*)(ws + WS_WR);
      for (int e = gt; e < 80 * DM; e += ngt) { const int n = e >> 11, k = e & 2047; const float v = n < 64 ? F.in[12][(size_t)k * 64 + n] : n < 72 ? F.in[11][(size_t)k * 8 + (n - 64)] : 0.f;
        const unsigned h = f2bf(v); const float hv = __uint_as_float(h << 16); wr[e] = (bf16)h; wr[80 * DM + e] = (bf16)f2bf(v - hv); } }
    { u32x4* P4 = (u32x4*)(ws + WS_P);
      for (int e = gt; e < NB * 112 * 768; e += ngt) { const int r = e / 768, ch = e - r * 768, b = r / 112, l = r - b * 112; P4[(size_t)(b * LPAD + l) * 768 + ch] = (u32x4){0u, 0u, 0u, 0u}; } }
    for (int m = F.gw; m < 16; m += F.ngw) rms_row_to_bf16(F.in[1] + (size_t)m * DM, F.in[2], (bf16*)(ws + WS_MISC + 4096) + (size_t)m * DM, F.lane);
    for (int m = F.gw; m < NTOK; m += F.ngw) rms_row_to_bf16(F.in[0] + (size_t)m * DM, F.in[2], (bf16*)(ws + WS_U) + (size_t)m * DM, F.lane);
    p0_weights<false>(F, 0, MK_GU_IN_P4 ? TR_I_IN + TR_I_OUT : MK_LATE_WD ? TR_ITEMS - TR_I_D : TR_ITEMS, F.gw, F.ngw);
}
__host__ __device__ __forceinline__ int tile_type(int pn) { return pn < 2 ? 0 : pn < 4 ? 1 : pn < 12 ? 2 : pn < 16 ? 3 : pn < 20 ? 4 : 2; }
struct EpiProj {
    static constexpr bool PERM = true;
    bf16* P; const f32x2* tret; const f32x2* tdiff;
    __device__ __forceinline__ void operator()(const f32x4 (&acc)[2][2][4][2], const pg8::Unit& u, int wr, int wc, int fr, int fq) const {
        const int ty = tile_type(u.pn), G = 4 * wc + fq;
        const float sc = ty == 1 ? QK_SCALE : ty == 3 ? QK_SCALE * LOG2E : 1.f;
        const bool rot = (ty == 0 || ty == 1) || ((ty == 3 || ty == 4) && wc == 0);
        const bool full = ty < 2;
        const int i0 = full ? 8 * (G & 7) : 8 * (fq & 1);
        const int d1 = full ? (G >> 3) * 128 + i0 : (fq >> 1) * 128 + i0, d2 = full ? d1 + 64 : d1 + 16;
#pragma unroll
        for (int ai = 0; ai < 2; ++ai) {
            f32x4 cst[4][4];
            if (rot) {
#pragma unroll
                for (int m = 0; m < 4; ++m) { const int t = (u.pm * 256 + ai * 128 + wr * 64 + m * 16 + fr) & 4095;
                    const f32x4* cs = (const f32x4*)((full ? tret + (size_t)(16 + t) * 64 : tdiff + (size_t)(16 + t) * 16) + i0);
                    cst[m][0] = cs[0]; cst[m][1] = cs[1]; cst[m][2] = cs[2]; cst[m][3] = cs[3]; }
            }
#pragma unroll
            for (int m = 0; m < 4; ++m) {
                const int R = u.pm * 256 + ai * 128 + wr * 64 + m * 16 + fr, b = R >> 12;
                bf16* rowp = P + (size_t)(R + 128 * (b + 1)) * NIN + u.pn * 256;
                const f32x4 a0 = acc[ai][0][m][0], a1 = acc[ai][0][m][1], b0 = acc[ai][1][m][0], b1 = acc[ai][1][m][1];
                if (rot) {
                    const f32x4 c01 = cst[m][0], c23 = cst[m][1], c45 = cst[m][2], c67 = cst[m][3];
                    u32x4 o1, o2;
#define ROT1(x1, x2, c, s) (((x1) * (c) - (x2) * (s)) * sc)
#define ROT2(x1, x2, c, s) (((x1) * (s) + (x2) * (c)) * sc)
                    o1.x = cvtpk(ROT1(a0[0], b0[0], c01[0], c01[1]), ROT1(a0[1], b0[1], c01[2], c01[3])); o1.y = cvtpk(ROT1(a0[2], b0[2], c23[0], c23[1]), ROT1(a0[3], b0[3], c23[2], c23[3]));
                    o1.z = cvtpk(ROT1(a1[0], b1[0], c45[0], c45[1]), ROT1(a1[1], b1[1], c45[2], c45[3])); o1.w = cvtpk(ROT1(a1[2], b1[2], c67[0], c67[1]), ROT1(a1[3], b1[3], c67[2], c67[3]));
                    o2.x = cvtpk(ROT2(a0[0], b0[0], c01[0], c01[1]), ROT2(a0[1], b0[1], c01[2], c01[3])); o2.y = cvtpk(ROT2(a0[2], b0[2], c23[0], c23[1]), ROT2(a0[3], b0[3], c23[2], c23[3]));
                    o2.z = cvtpk(ROT2(a1[0], b1[0], c45[0], c45[1]), ROT2(a1[1], b1[1], c45[2], c45[3])); o2.w = cvtpk(ROT2(a1[2], b1[2], c67[0], c67[1]), ROT2(a1[3], b1[3], c67[2], c67[3]));
#undef ROT1
#undef ROT2
                    *(u32x4*)(rowp + d1) = o1; *(u32x4*)(rowp + d2) = o2;
                } else {
                    u32x4 o1, o2;
                    o1.x = cvtpk(a0[0] * sc, a0[1] * sc); o1.y = cvtpk(a0[2] * sc, a0[3] * sc); o1.z = cvtpk(a1[0] * sc, a1[1] * sc); o1.w = cvtpk(a1[2] * sc, a1[3] * sc);
                    o2.x = cvtpk(b0[0] * sc, b0[1] * sc); o2.y = cvtpk(b0[2] * sc, b0[3] * sc); o2.z = cvtpk(b1[0] * sc, b1[1] * sc); o2.w = cvtpk(b1[2] * sc, b1[3] * sc);
                    *(u32x4*)(rowp + 8 * G) = o1; *(u32x4*)(rowp + 128 + 8 * G) = o2;
                }
            }
        }
    }
};
__device__ __forceinline__ void meta_proj_task(Frame& F, int task) {
    const int lane = F.lane, g = lane >> 4, li = lane & 15, w = F.wave;
    const int tsel = task >> 3, j8 = task & 7;
    const int pn = tsel < 2 ? 2 + tsel : tsel < 6 ? 4 + (tsel - 2) : 16 + (tsel - 6);
    const bf16* um = (const bf16*)(F.ws + WS_MISC + 4096);
    const bf16* wt = (const bf16*)(F.ws + WS_WIN);
    const bf16* ap = um + (size_t)li * DM + 8 * g + 256 * w;
    const bf16* bp0 = wt + (size_t)(pn * 256 + 16 * j8 + li) * DM + 8 * g + 256 * w;
    const bf16* bp1 = bp0 + (size_t)128 * DM;
    bf16x8 a[8], b0[8], b1[8];
#pragma unroll
    for (int s = 0; s < 8; ++s) { a[s] = *(const bf16x8*)(ap + 32 * s); b0[s] = *(const bf16x8*)(bp0 + 32 * s); b1[s] = *(const bf16x8*)(bp1 + 32 * s); }
    f32x4 accA = {0.f, 0.f, 0.f, 0.f}, accB = {0.f, 0.f, 0.f, 0.f};
#pragma unroll
    for (int s = 0; s < 8; ++s) { accA = __builtin_amdgcn_mfma_f32_16x16x32_bf16(a[s], b0[s], accA, 0, 0, 0); accB = __builtin_amdgcn_mfma_f32_16x16x32_bf16(a[s], b1[s], accB, 0, 0, 0); }
    LAS f32x4* red = (LAS f32x4*)F.lds;
    red[(w * 2 + 0) * 64 + lane] = accA; red[(w * 2 + 1) * 64 + lane] = accB;
    __syncthreads();
    if (w == 0) {
#pragma unroll
        for (int ww = 1; ww < 8; ++ww) { accA += red[(ww * 2 + 0) * 64 + lane]; accB += red[(ww * 2 + 1) * 64 + lane]; }
        const int ty = tile_type(pn), c = 16 * j8 + li;
        const f32x2* tret = (const f32x2*)(F.ws + WS_TAB_RET); const f32x2* tdiff = (const f32x2*)(F.ws + WS_TAB_DIFF);
        bf16* P = (bf16*)(F.ws + WS_P);
#pragma unroll
        for (int r = 0; r < 4; ++r) {
            const int row = 4 * g + r;
            float x1 = accA[r], x2 = accB[r]; int c1 = c, c2 = 128 + c;
            if (ty == 1) { const int head2 = c >> 6, i = c & 63; const f32x2 cs = tret[row * 64 + i]; const float y1 = (x1 * cs.x - x2 * cs.y) * QK_SCALE, y2 = (x1 * cs.y + x2 * cs.x) * QK_SCALE;
                x1 = y1; x2 = y2; c1 = head2 * 128 + i; c2 = c1 + 64; }
            else if (ty == 4 && c < 32) { const int comp = c >> 4, i = c & 15; const f32x2 cs = tdiff[row * 16 + i]; const float y1 = x1 * cs.x - x2 * cs.y, y2 = x1 * cs.y + x2 * cs.x;
                x1 = y1; x2 = y2; c1 = comp * 128 + i; c2 = c1 + 16; }
            const bf16 h1 = (bf16)f2bf(x1), h2 = (bf16)f2bf(x2);
#pragma unroll
            for (int b = 0; b < NB; ++b) { bf16* rowp = P + (size_t)(b * LPAD + 112 + row) * NIN + pn * 256; rowp[c1] = h1; rowp[c2] = h2; }
        }
    }
    __syncthreads();
}
struct EpiH1 {
    static constexpr bool PERM = false;
    const float* x; float* out; float* ss;
    __device__ __forceinline__ void operator()(const f32x4 (&acc)[2][2][4][2], const pg8::Unit& u, int wr, int wc, int fr, int fq) const {
        const int col0 = u.pn * 256 + wc * 32 + 4 * fq;
#pragma unroll
        for (int ai = 0; ai < 2; ++ai) {
            f32x4 xv[4][2][2];
#pragma unroll
            for (int m = 0; m < 4; ++m) { const size_t off = (size_t)(u.pm * 256 + ai * 128 + wr * 64 + m * 16 + fr) * DM + col0;
#pragma unroll
                for (int bj = 0; bj < 2; ++bj)
#pragma unroll
                    for (int n = 0; n < 2; ++n) xv[m][bj][n] = *(const f32x4*)(x + off + bj * 128 + n * 16); }
#pragma unroll
            for (int m = 0; m < 4; ++m) {
                const int R = u.pm * 256 + ai * 128 + wr * 64 + m * 16 + fr; const size_t off = (size_t)R * DM + col0; float s = 0.f;
#pragma unroll
                for (int bj = 0; bj < 2; ++bj)
#pragma unroll
                    for (int n = 0; n < 2; ++n) { const f32x4 h = xv[m][bj][n] + acc[ai][bj][m][n]; *(f32x4*)(out + off + bj * 128 + n * 16) = h;
                        s += (h[0] * h[0] + h[1] * h[1]) + (h[2] * h[2] + h[3] * h[3]); }
                s += __shfl_xor(s, 16); s += __shfl_xor(s, 32);
                if (fq == 0) ss[(size_t)R * 32 + u.pn * 4 + wc] = s;
            }
        }
    }
};
struct MoeSched {
    const LAS int* tb; const LAS int* cnt; const LAS unsigned* rowtab; const LAS int* pt; const int* list; int NT, x, j, nj;
    __device__ __forceinline__ bool next(int i, pg8::Unit& u) const {
        const int l = i * nj + j; if (l >= pt[8] * NT) return false;
        const int tq = l / NT, nt = l - tq * NT; int k = 0;
#pragma unroll
        for (int s = 1; s < 8; ++s) if (pt[s] <= tq) k = s;
        const int e = pt[16 + k]; u.pm = tb[e] + (tq - pt[k]); u.pn = e * NT + nt; u.aux = i; return true; }
    __device__ __forceinline__ unsigned rowoff(const pg8::Unit& u, int row) const { if (u.aux < 7) return rowtab[u.aux * 256 + row];
        const int e = u.pn / NT, r = (u.pm - tb[e]) * 256 + row; return (unsigned)list[(size_t)e * NTOK + (r < cnt[e] ? r : 0)] * (unsigned)(DM * 2); }
};
__device__ __forceinline__ float silu_f(float g) { return g * __builtin_amdgcn_rcpf(1.0f + __builtin_amdgcn_exp2f(-g * LOG2E)); }
struct EpiAct {
    static constexpr bool PERM = true;
    bf16* H;
    __device__ __forceinline__ void operator()(const f32x4 (&acc)[2][2][4][2], const pg8::Unit& u, int wr, int wc, int fr, int fq) const {
        const int nt = u.pn & 3, G = 4 * wc + fq; const bool half = false;
#pragma unroll
        for (int ai = 0; ai < 2; ++ai) { if (ai == 1 && half) break;
#pragma unroll
            for (int m = 0; m < 4; ++m) {
                const int row = u.pm * 256 + ai * 128 + wr * 64 + m * 16 + fr;
                const f32x4 g0 = acc[ai][0][m][0], g1 = acc[ai][0][m][1], u0 = acc[ai][1][m][0], u1 = acc[ai][1][m][1];
                u32x4 o; o.x = cvtpk(silu_f(g0[0]) * u0[0], silu_f(g0[1]) * u0[1]); o.y = cvtpk(silu_f(g0[2]) * u0[2], silu_f(g0[3]) * u0[3]);
                o.z = cvtpk(silu_f(g1[0]) * u1[0], silu_f(g1[1]) * u1[1]); o.w = cvtpk(silu_f(g1[2]) * u1[2], silu_f(g1[3]) * u1[3]);
                *(u32x4*)(H + (size_t)row * FF + nt * 128 + 8 * G) = o;
            } }
    }
};
struct EpiY {
    static constexpr bool PERM = true;
    bf16* Y; const LAS int* tb; const LAS int* cnt;
    __device__ __forceinline__ void operator()(const f32x4 (&acc)[2][2][4][2], const pg8::Unit& u, int wr, int wc, int fr, int fq) const {
        const int e = u.pn >> 3, nt = u.pn & 7, G = 4 * wc + fq, r0 = (u.pm - tb[e]) * 256, ce = cnt[e]; const bool half = r0 + 128 >= ce;
#pragma unroll
        for (int ai = 0; ai < 2; ++ai) { if (ai == 1 && half) break;
#pragma unroll
            for (int m = 0; m < 4; ++m) {
                const int rt = ai * 128 + wr * 64 + m * 16 + fr;
                bf16* rowp = Y + (size_t)(u.pm * 256 + rt) * DM + nt * 256 + 8 * G;
#pragma unroll
                for (int bj = 0; bj < 2; ++bj) { const f32x4 v0 = acc[ai][bj][m][0], v1 = acc[ai][bj][m][1];
                    u32x4 o; o.x = cvtpk(v0[0], v0[1]); o.y = cvtpk(v0[2], v0[3]); o.z = cvtpk(v1[0], v1[1]); o.w = cvtpk(v1[2], v1[3]);
                    *(u32x4*)(rowp + bj * 128) = o; }
            } }
    }
};
constexpr int AT_KS = 528, AT_VS = 544, AT_KB = 32 * AT_KS, AT_VB = 32 * AT_VS, AT_BUF = AT_KB + AT_VB, AT_SCR = 2 * AT_BUF;
static_assert(AT_SCR + NWAVES * 256 <= RING_BYTES, "attention LDS");
typedef short v4i16_t __attribute__((ext_vector_type(4)));
__device__ __forceinline__ s16x4 trr(const LAS unsigned char* p) { return __builtin_bit_cast(s16x4, __builtin_amdgcn_ds_read_tr16_b64_v4i16((LAS v4i16_t*)p)); }
#define MFMA16(a, b, c) __builtin_amdgcn_mfma_f32_16x16x32_bf16(a, b, c, 0, 0, 0)
#define BV8(lo, hi) (bf16x8){lo[0], lo[1], lo[2], lo[3], hi[0], hi[1], hi[2], hi[3]}
__device__ __forceinline__ float fexp2(float x) { return __builtin_amdgcn_exp2f(x); }

__device__ __forceinline__ void sm16(f32x4 (&s)[2], float& m, float& l, float& alpha, bf16x8& pa) {
    float mx = fmaxf(fmaxf(fmaxf(s[0][0], s[0][1]), fmaxf(s[0][2], s[0][3])), fmaxf(fmaxf(s[1][0], s[1][1]), fmaxf(s[1][2], s[1][3])));
    mx = xmax32(xmax16(mx));
    const float mn = fmaxf(m, mx); alpha = fexp2(m - mn); m = mn;
    float ps = 0.f;
#pragma unroll
    for (int kb = 0; kb < 2; ++kb)
#pragma unroll
        for (int r = 0; r < 4; ++r) { s[kb][r] = fexp2(s[kb][r] - mn); ps += s[kb][r]; }
    l = l * alpha + ps;
    u32x4 w; w.x = cvtpk(s[0][0], s[0][1]); w.y = cvtpk(s[0][2], s[0][3]); w.z = cvtpk(s[1][0], s[1][1]); w.w = cvtpk(s[1][2], s[1][3]);
    pa = __builtin_bit_cast(bf16x8, w);
}

constexpr int DA_RS = 1056, DA_BUF = 64 * DA_RS, DA_SCR = 2 * DA_BUF;
static_assert(DA_SCR + NWAVES * 128 <= LDSCTL_OFF && 8 * 16 * 64 * 16 <= DA_SCR, "attention LDS");
__device__ __forceinline__ void glds16s(unsigned voff, const void* sbase, unsigned lds_dst) { unsigned keep;
    asm volatile("s_mov_b32 %0, m0\n\ts_mov_b32 m0, %3\n\ts_nop 0\n\tglobal_load_lds_dwordx4 %1, %2\n\ts_mov_b32 m0, %0" : "=&s"(keep) : "v"(voff), "s"(sbase), "s"(lds_dst) : "memory"); }
__device__ __forceinline__ const char* uniform_ptr(const char* p) { const unsigned long long v = (unsigned long long)(uintptr_t)p;
    return (const char*)(uintptr_t)(((unsigned long long)(unsigned)__builtin_amdgcn_readfirstlane((int)(v >> 32)) << 32) | (unsigned)__builtin_amdgcn_readfirstlane((int)(unsigned)v)); }
__device__ __forceinline__ void diff_unit(Frame& F, int b, int h, int qb) {
    LAS unsigned char* lds = F.lds;
    const int lane = F.lane, w = F.wave, g = lane >> 4, li = lane & 15, rg = w & 3, cp = w >> 2;
    const bf16* Pb = (const bf16*)(F.ws + WS_P) + (size_t)b * LPAD * NIN;
    const int Q0 = 128 + 128 * qb, qrow = Q0 + 32 * rg, ntiles = 3 + 2 * qb;
    bf16x8 qf[2][4];
#pragma unroll
    for (int rb = 0; rb < 2; ++rb) { const bf16* qp = Pb + (size_t)(qrow + 16 * rb + li) * NIN + C_DQ + h * 256 + cp * 128 + 8 * g;
#pragma unroll
        for (int s = 0; s < 4; ++s) qf[rb][s] = *(const bf16x8*)(qp + 32 * s); }
    const char* gk = uniform_ptr((const char*)Pb + (size_t)((C_DK + h * 256) * 2));
    const unsigned dvo = (unsigned)(16 * lane + (lane >= 32 ? ((C_DV - C_DK) * 2 - 512) : 0));
    const unsigned ldsbase = (unsigned)(uintptr_t)lds;
#define DA_DMA(l0, bf) do { _Pragma("unroll") for (int i_ = 0; i_ < 8; ++i_) glds16s(dvo, gk + (size_t)((l0) + w + 8 * i_) * (NIN * 2), (unsigned)__builtin_amdgcn_readfirstlane(ldsbase + (bf) * DA_BUF + (w + 8 * i_) * DA_RS)); } while (0)
#define DA_WAITBAR() asm volatile("s_waitcnt vmcnt(0) lgkmcnt(0)\n\ts_barrier" ::: "memory")
    const int kra = li * DA_RS + cp * 256 + g * 16;
    const int vra = 512 + (4 * g + (li >> 2)) * DA_RS + (li & 3) * 8;
    LAS float* scr = (LAS float*)(lds + DA_SCR + w * 128);
    float m[2] = {-1e30f, -1e30f}, l[2] = {0.f, 0.f};
    f32x4 o[2][16];
#pragma unroll
    for (int rb = 0; rb < 2; ++rb)
#pragma unroll
        for (int c = 0; c < 16; ++c) o[rb][c] = (f32x4){0.f, 0.f, 0.f, 0.f};
    DA_DMA(64, 0); DA_WAITBAR();
    for (int j = 0; j < ntiles; ++j) {
        const int l0 = 64 + 64 * j; const LAS unsigned char* tb = lds + (j & 1) * DA_BUF;
        if (j + 1 < ntiles) DA_DMA(l0 + 64, (j + 1) & 1);
        if (l0 <= qrow + 31) {
            f32x4 s[2][4];
#pragma unroll
            for (int kb = 0; kb < 4; ++kb) { s[0][kb] = (f32x4){0.f, 0.f, 0.f, 0.f}; s[1][kb] = (f32x4){0.f, 0.f, 0.f, 0.f};
                if (j > 0 || kb == 3) {
#pragma unroll
                for (int sd = 0; sd < 4; ++sd) { const bf16x8 a = *(const LAS bf16x8*)(tb + kra + kb * 16 * DA_RS + sd * 64); s[0][kb] = MFMA16(a, qf[0][sd], s[0][kb]); s[1][kb] = MFMA16(a, qf[1][sd], s[1][kb]); } } }
            if (j == 0 || l0 + 63 > qrow) {
#pragma unroll
                for (int rb = 0; rb < 2; ++rb)
#pragma unroll
                    for (int kb = 0; kb < 4; ++kb)
#pragma unroll
                        for (int r = 0; r < 4; ++r) { const int key = l0 + 16 * kb + 4 * g + r; if (key < 112 || key > qrow + 16 * rb + li) s[rb][kb][r] = -1e30f; }
            }
            bf16x8 pa[2][2]; float alpha[2];
#pragma unroll
            for (int rb = 0; rb < 2; ++rb) {
                float mx = fmaxf(fmaxf(s[rb][0][0], s[rb][0][1]), fmaxf(s[rb][0][2], s[rb][0][3]));
#pragma unroll
                for (int kb = 1; kb < 4; ++kb) mx = fmaxf(fmaxf(mx, fmaxf(s[rb][kb][0], s[rb][kb][1])), fmaxf(s[rb][kb][2], s[rb][kb][3]));
                mx = xmax32(xmax16(mx));
                const bool keep = (mx - m[rb] <= 8.0f);
                const float mn = keep ? m[rb] : fmaxf(m[rb], mx); alpha[rb] = keep ? 1.0f : fexp2(m[rb] - mn); m[rb] = mn;
                float ps = 0.f;
#pragma unroll
                for (int kb = 0; kb < 4; ++kb)
#pragma unroll
                    for (int r = 0; r < 4; ++r) { s[rb][kb][r] = fexp2(s[rb][kb][r] - mn); ps += s[rb][kb][r]; }
                l[rb] = l[rb] * alpha[rb] + ps;
#pragma unroll
                for (int t = 0; t < 2; ++t) { u32x4 pw; pw.x = cvtpk(s[rb][2 * t][0], s[rb][2 * t][1]); pw.y = cvtpk(s[rb][2 * t][2], s[rb][2 * t][3]); pw.z = cvtpk(s[rb][2 * t + 1][0], s[rb][2 * t + 1][1]); pw.w = cvtpk(s[rb][2 * t + 1][2], s[rb][2 * t + 1][3]);
                    pa[rb][t] = __builtin_bit_cast(bf16x8, pw); }
            }
            if (__any(alpha[0] < 1.f || alpha[1] < 1.f)) {
                if (g == 0) { scr[li] = alpha[0]; scr[16 + li] = alpha[1]; }
                LDS_WAIT();
                const f32x4 a0 = *(const LAS f32x4*)(scr + 4 * g), a1 = *(const LAS f32x4*)(scr + 16 + 4 * g);
#pragma unroll
                for (int c = 0; c < 16; ++c) { o[0][c] *= a0; o[1][c] *= a1; }
                LDS_WAIT();
            }
#pragma unroll
            for (int t = 0; t < 2; ++t) { if (j > 0 || t == 1) {
#pragma unroll
                for (int c = 0; c < 16; ++c) { const s16x4 lo = trr(tb + vra + (32 * t) * DA_RS + c * 32), hi = trr(tb + vra + (32 * t + 16) * DA_RS + c * 32); const bf16x8 bv = BV8(lo, hi);
                    o[0][c] = MFMA16(pa[0][t], bv, o[0][c]); o[1][c] = MFMA16(pa[1][t], bv, o[1][c]); if ((c & 3) == 3) __builtin_amdgcn_sched_barrier(0); } } }
        }
        DA_WAITBAR();
    }
    { const float lam = *(const float*)(F.ws + WS_MISC);
#pragma unroll
      for (int rb = 0; rb < 2; ++rb) { const float lt = xsum32(xsum16(l[rb])); if (g == 0) scr[16 * rb + li] = cp ? lam / lt : 1.0f / lt; }
      LDS_WAIT();
      const f32x4 f0 = *(const LAS f32x4*)(scr + 4 * g), f1 = *(const LAS f32x4*)(scr + 16 + 4 * g);
#pragma unroll
      for (int c = 0; c < 16; ++c) { o[0][c] *= f0; o[1][c] *= f1; } }
    LAS f32x4* xb = (LAS f32x4*)lds + (size_t)rg * 2048 + lane;
    if (cp) {
#pragma unroll
        for (int rb = 0; rb < 2; ++rb)
#pragma unroll
            for (int c = 0; c < 16; ++c) xb[(rb * 16 + c) * 64] = o[rb][c];
    }
    __syncthreads();
    if (!cp) {
        const float* gs = F.in[9];
        float gv16[16];
#pragma unroll
        for (int c = 0; c < 16; ++c) gv16[c] = gs[16 * c + li] * (1.0f - LAMBDA_INIT);
#pragma unroll
        for (int rb = 0; rb < 2; ++rb) {
            f32x4 ss = {0.f, 0.f, 0.f, 0.f};
#pragma unroll
            for (int c = 0; c < 16; ++c) { o[rb][c] -= xb[(rb * 16 + c) * 64]; ss += o[rb][c] * o[rb][c]; }
#pragma unroll
            for (int r = 0; r < 4; ++r) { float v = ss[r]; v += __shfl_xor(v, 1); v += __shfl_xor(v, 2); v += __shfl_xor(v, 4); v += __shfl_xor(v, 8); ss[r] = 1.0f / sqrtf(v * (1.f / 256.f) + EPS); }
            bf16* mx = (bf16*)(F.ws + WS_MIXED) + (size_t)(b * SEQ + 128 * qb + 32 * rg + 16 * rb + 4 * g) * DM + 1024 + h * 256 + li;
#pragma unroll
            for (int c = 0; c < 16; ++c) { const float gv = gv16[c];
#pragma unroll
                for (int r = 0; r < 4; ++r) mx[(size_t)r * DM + 16 * c] = (bf16)f2bf(o[rb][c][r] * ss[r] * gv); }
        }
    }
    __syncthreads();
#undef DA_DMA
#undef DA_WAITBAR
}

__device__ __forceinline__ float ret_log2g(int h) { return log2f(1.0f - 1.0f / (float)(32 << h)); }
__device__ __forceinline__ void ret_kv_unit(Frame& F, int b, int h, int c  ) {
    LAS unsigned char* lds = F.lds;
    const int tid = F.tid, lane = F.lane, w = F.wave, g = lane >> 4, li = lane & 15;
    const bf16* Pb = (const bf16*)(F.ws + WS_P) + (size_t)(b * LPAD + 128 * c) * NIN;
    const float lg = ret_log2g(h);
    const int krow = tid >> 4, kch = tid & 15, srow = tid >> 5, sch = tid & 31;
    const bf16* kg = Pb + (size_t)krow * NIN + C_RK + h * 128 + kch * 8;
    const bf16* vg = Pb + (size_t)srow * NIN + C_RV + h * 256 + sch * 8;
    const int kst = krow * AT_KS + kch * 16, vst = AT_KB + srow * AT_VS + sch * 16;
    u32x4 st[3];
#define K_LOADT(i) do { const size_t o_ = (size_t)(32 * (i)) * NIN; st[0] = *(const u32x4*)(kg + o_); st[1] = *(const u32x4*)(vg + o_); st[2] = *(const u32x4*)(vg + o_ + 16 * NIN); } while (0)
#define K_WRITET(bf, i) do { LAS unsigned char* d_ = lds + (bf) * AT_BUF; const float z_ = fexp2((float)(127 - 32 * (i) - krow) * lg); u32x4 k_; \
        k_.x = cvtpk(bf_lo(st[0].x) * z_, bf_hi(st[0].x) * z_); k_.y = cvtpk(bf_lo(st[0].y) * z_, bf_hi(st[0].y) * z_); k_.z = cvtpk(bf_lo(st[0].z) * z_, bf_hi(st[0].z) * z_); k_.w = cvtpk(bf_lo(st[0].w) * z_, bf_hi(st[0].w) * z_); \
        *(LAS u32x4*)(d_ + kst) = k_; *(LAS u32x4*)(d_ + vst) = st[1]; *(LAS u32x4*)(d_ + vst + 16 * AT_VS) = st[2]; } while (0)
    const int ara = (4 * g + (li >> 2)) * AT_KS + (16 * w + 4 * (li & 3)) * 2;
    const int vra = AT_KB + (4 * g + (li >> 2)) * AT_VS + (li & 3) * 8;
    f32x4 acc[16];
#pragma unroll
    for (int cc = 0; cc < 16; ++cc) acc[cc] = (f32x4){0.f, 0.f, 0.f, 0.f};
    K_LOADT(0); K_WRITET(0, 0); K_LOADT(1); __syncthreads();
#pragma unroll
    for (int i = 0; i < 4; ++i) {
        const LAS unsigned char* tb = lds + (i & 1) * AT_BUF;
        const s16x4 alo = trr(tb + ara), ahi = trr(tb + ara + 16 * AT_KS); const bf16x8 af = BV8(alo, ahi);
        if (i + 1 < 4) K_WRITET((i + 1) & 1, i + 1);
        if (i + 2 < 4) K_LOADT(i + 2);
#pragma unroll
        for (int cc = 0; cc < 16; ++cc) { const s16x4 lo = trr(tb + vra + cc * 32), hi = trr(tb + vra + 16 * AT_VS + cc * 32); acc[cc] = MFMA16(af, BV8(lo, hi), acc[cc]); }
        __syncthreads();
    }
#undef K_LOADT
#undef K_WRITET
    bf16* kv = (bf16*)(F.ws + WS_KV) + ((size_t)((b * 4 + h) * 32 + c) * 128 + 16 * w + 4 * g) * 256 + li;
#pragma unroll
    for (int cc = 0; cc < 16; ++cc)
#pragma unroll
        for (int r = 0; r < 4; ++r) kv[(size_t)r * 256 + 16 * cc] = (bf16)f2bf(acc[cc][r]);
}
__device__ __forceinline__ void ret_scan(Frame& F) {
    const int gt = F.gw * 64 + F.lane, ngt = F.ngw * 64;
    for (int e = gt; e < 16 * 128 * 64; e += ngt) {
        const int bh = e >> 13, rem = e & 8191;
        const float dec = fexp2(128.0f * ret_log2g(bh & 3));
        const u32x2* kv = (const u32x2*)(F.ws + WS_KV) + (size_t)bh * 32 * 8192 + rem;
        u32x2* sb = (u32x2*)(F.ws + WS_S) + (size_t)bh * 32 * 8192 + rem;
        f32x4 s = {0.f, 0.f, 0.f, 0.f};
#pragma unroll 8
        for (int c = 0; c < 32; ++c) { const u32x2 q = kv[(size_t)c * 8192]; const f32x4 inc = {bf_lo(q.x), bf_hi(q.x), bf_lo(q.y), bf_hi(q.y)};
            s = s * dec + inc; u32x2 o; o.x = cvtpk(s[0], s[1]); o.y = cvtpk(s[2], s[3]); sb[(size_t)c * 8192] = o; }
    }
}
__device__ __forceinline__ void ret_out_unit(Frame& F, int b, int h, int c  ) {
    LAS unsigned char* lds = F.lds;
    int tid = F.tid; asm volatile("" : "+v"(tid));
    const int lane = tid & 63, w = F.wave, g = lane >> 4, li = lane & 15;
    const bf16* Pb = (const bf16*)(F.ws + WS_P) + (size_t)(b * LPAD + 128 * c) * NIN;
    const bf16* Sb = (const bf16*)(F.ws + WS_S) + (size_t)((b * 4 + h) * 32 + (c - 1)) * 128 * 256;
    const float lg = ret_log2g(h);
    bf16x8 qf[4];
    { const bf16* qp = Pb + (size_t)(16 * w + li) * NIN + C_RQ + h * 128 + 8 * g;
#pragma unroll
      for (int s = 0; s < 4; ++s) qf[s] = *(const bf16x8*)(qp + 32 * s); }
    const int krow = tid >> 4, kch = tid & 15, srow = tid >> 5, sch = tid & 31;
    const int rho = 16 * ((srow >> 2) & 1) + 4 * (srow >> 3) + (srow & 3);
    const bf16* sg = Sb + (size_t)srow * 256 + sch * 8;
    const bf16* kg = Pb + (size_t)krow * NIN + C_RK + h * 128 + kch * 8;
    const bf16* vg = Pb + (size_t)srow * NIN + C_RV + h * 256 + sch * 8;
    const int kst = krow * AT_KS + kch * 16, vst = AT_KB + srow * AT_VS + sch * 16, sst = AT_KB + rho * AT_VS + sch * 16;
    u32x4 st[3];
#define R_LOAD(j) do { if ((j) < 4) { const size_t o_ = (size_t)(32 * (j)) * 256; st[1] = *(const u32x4*)(sg + o_); st[2] = *(const u32x4*)(sg + o_ + 16 * 256); } \
        else { const size_t o_ = (size_t)(32 * ((j) - 4)) * NIN; st[0] = *(const u32x4*)(kg + o_); st[1] = *(const u32x4*)(vg + o_); st[2] = *(const u32x4*)(vg + o_ + 16 * NIN); } } while (0)
#define R_WRITE(bf, j) do { LAS unsigned char* d_ = lds + (bf) * AT_BUF; if ((j) < 4) { *(LAS u32x4*)(d_ + sst) = st[1]; *(LAS u32x4*)(d_ + sst + 8 * AT_VS) = st[2]; } \
        else { *(LAS u32x4*)(d_ + kst) = st[0]; *(LAS u32x4*)(d_ + vst) = st[1]; *(LAS u32x4*)(d_ + vst + 16 * AT_VS) = st[2]; } } while (0)
    const int kra = li * AT_KS + g * 16;
    const int vra = AT_KB + (4 * g + (li >> 2)) * AT_VS + (li & 3) * 8;
    f32x4 o[16];
#pragma unroll
    for (int cc = 0; cc < 16; ++cc) o[cc] = (f32x4){0.f, 0.f, 0.f, 0.f};
    R_LOAD(0); R_WRITE(0, 0); R_LOAD(1); __syncthreads();
#pragma unroll
    for (int j = 0; j < 8; ++j) {
        const LAS unsigned char* tb = lds + (j & 1) * AT_BUF;
        if (j < 4) {
            if (j + 1 < 8) R_WRITE((j + 1) & 1, j + 1);
            if (j + 2 < 8) R_LOAD(j + 2);
#pragma unroll
            for (int cc = 0; cc < 16; ++cc) { const s16x4 lo = trr(tb + vra + cc * 32), hi = trr(tb + vra + 16 * AT_VS + cc * 32); o[cc] = MFMA16(qf[j & 3], BV8(lo, hi), o[cc]); }
            if (j == 3) {
                f32x4 xi;
#pragma unroll
                for (int r = 0; r < 4; ++r) xi[r] = fexp2((float)(16 * w + 4 * g + r + 1) * lg);
#pragma unroll
                for (int cc = 0; cc < 16; ++cc) o[cc] *= xi;
            }
        } else {
            const int i = j - 4;
            bf16x8 pa; bool live = (32 * i <= 16 * w + 15);
            if (live) {
                f32x4 s[2];
#pragma unroll
                for (int kb = 0; kb < 2; ++kb) { s[kb] = (f32x4){0.f, 0.f, 0.f, 0.f};
#pragma unroll
                    for (int sd = 0; sd < 4; ++sd) { const bf16x8 a = *(const LAS bf16x8*)(tb + kra + kb * 16 * AT_KS + sd * 64); s[kb] = MFMA16(a, qf[sd], s[kb]); } }
#pragma unroll
                for (int kb = 0; kb < 2; ++kb)
#pragma unroll
                    for (int r = 0; r < 4; ++r) { const int d = (16 * w + li) - (32 * i + 16 * kb + 4 * g + r); s[kb][r] = d >= 0 ? s[kb][r] * fexp2((float)d * lg) : 0.f; }
                u32x4 pw; pw.x = cvtpk(s[0][0], s[0][1]); pw.y = cvtpk(s[0][2], s[0][3]); pw.z = cvtpk(s[1][0], s[1][1]); pw.w = cvtpk(s[1][2], s[1][3]);
                pa = __builtin_bit_cast(bf16x8, pw);
            }
            if (j + 1 < 8) R_WRITE((j + 1) & 1, j + 1);
            if (j + 2 < 8) R_LOAD(j + 2);
            if (live) {
#pragma unroll
                for (int cc = 0; cc < 16; ++cc) { const s16x4 lo = trr(tb + vra + cc * 32), hi = trr(tb + vra + 16 * AT_VS + cc * 32); o[cc] = MFMA16(pa, BV8(lo, hi), o[cc]); }
            }
        }
        __syncthreads();
    }
#undef R_LOAD
#undef R_WRITE
    f32x4 ss = {0.f, 0.f, 0.f, 0.f};
#pragma unroll
    for (int cc = 0; cc < 16; ++cc) ss += o[cc] * o[cc];
#pragma unroll
    for (int r = 0; r < 4; ++r) { float v = ss[r]; v += __shfl_xor(v, 1); v += __shfl_xor(v, 2); v += __shfl_xor(v, 4); v += __shfl_xor(v, 8); ss[r] = 1.0f / sqrtf(v * (1.f / 256.f) + EPS); }
    const bf16* gp = Pb + (size_t)(16 * w + 4 * g) * NIN + C_RG + h * 256 + li;
    bf16* mx = (bf16*)(F.ws + WS_MIXED) + (size_t)(b * SEQ + 128 * (c - 1) + 16 * w + 4 * g) * DM + h * 256 + li;
    unsigned gq[16][2];
#pragma unroll
    for (int cc = 0; cc < 16; ++cc)
#pragma unroll
        for (int r2 = 0; r2 < 2; ++r2) gq[cc][r2] = (unsigned)gp[(size_t)(2 * r2) * NIN + 16 * cc] | ((unsigned)gp[(size_t)(2 * r2 + 1) * NIN + 16 * cc] << 16);
#pragma unroll
    for (int cc = 0; cc < 16; ++cc)
#pragma unroll
        for (int r = 0; r < 4; ++r) { const float gt = (r & 1) ? bf_hi(gq[cc][r >> 1]) : bf_lo(gq[cc][r >> 1]); mx[(size_t)r * DM + 16 * cc] = (bf16)f2bf(silu_f(gt) * o[cc][r] * ss[r]); }
}
__device__ __forceinline__ void router_select(Frame& F, const LAS float* row, int tok) {
    int gs = 0; float gm = row[64];
#pragma unroll
    for (int j = 1; j < 8; ++j) { const float v = row[64 + j]; if (v > gm) { gm = v; gs = j; } }
    float gsum = 0.f;
#pragma unroll
    for (int j = 0; j < 8; ++j) gsum += __expf(row[64 + j] - gm);
    const float ggate = 1.0f / gsum;
    const LAS float* er = row + 8 * gs;
    int i1 = 0; float e1 = er[0];
#pragma unroll
    for (int j = 1; j < 8; ++j) { const float v = er[j]; if (v > e1) { e1 = v; i1 = j; } }
    int i2 = -1; float e2 = -3.0e38f;
#pragma unroll
    for (int j = 0; j < 8; ++j) { const float v = er[j]; if (j != i1 && v > e2) { e2 = v; i2 = j; } }
    const float t = __expf(e2 - e1), pa = 1.0f / (1.0f + t), pb = t * pa;
    const int ea = 8 * gs + i1, eb = 8 * gs + i2;
    gu32* cnt = F.ctl + CW_CNT + 32 * F.dup;
    const int ra = (int)__hip_atomic_fetch_add(cnt + 64 * ea, 1u, RLX_AGENT), rb2 = (int)__hip_atomic_fetch_add(cnt + 64 * eb, 1u, RLX_AGENT);
    int* list = (int*)(F.ws + (F.dup ? WS_KV : WS_LIST)); f32x2* wtok = (f32x2*)(F.ws + (F.dup ? WS_KV + 4 * MiB : WS_WL));
    list[(size_t)ea * NTOK + ra] = tok; list[(size_t)eb * NTOK + rb2] = tok;
    wtok[tok] = (f32x2){ggate * pa, ggate * pb};
    ((int4*)(F.ws + (F.dup ? WS_KV + 8 * MiB : WS_TOKSLOT)))[tok] = make_int4(ea, ra, eb, rb2);
}
__device__ __forceinline__ void router_task(Frame& F, int task) {
    const int lane = F.lane, g = lane >> 4, li = lane & 15, w = F.wave, r0 = 64 * task, k0 = 256 * w;
    const f32x4* ss = (const f32x4*)(F.ws + WS_SSP);
    const float* h1 = F.out + (size_t)(r0 + li) * DM + k0 + 8 * g;
    float rstd[4];
#pragma unroll
    for (int rb = 0; rb < 4; ++rb) { const f32x4* p = ss + (size_t)(r0 + 16 * rb + li) * 8; float t = 0.f;
#pragma unroll
        for (int q = 0; q < 8; ++q) { const f32x4 v = p[q]; t += (v[0] + v[1]) + (v[2] + v[3]); }
        rstd[rb] = 1.0f / sqrtf(t * (1.f / DM) + EPS); }
    const float* g2 = F.in[10] + k0 + 8 * g;
    bf16* up = (bf16*)(F.ws + WS_U) + (size_t)(r0 + li) * DM + k0 + 8 * g;
    const bf16* whi = (const bf16*)(F.ws + WS_WR) + (size_t)li * DM + k0 + 8 * g; const bf16* wlo = whi + 80 * DM;
    f32x4 acc[4][5];
#pragma unroll
    for (int rb = 0; rb < 4; ++rb)
#pragma unroll
        for (int cb = 0; cb < 5; ++cb) acc[rb][cb] = (f32x4){0.f, 0.f, 0.f, 0.f};
    const __amdgpu_buffer_rsrc_t rsH = __builtin_amdgcn_make_buffer_rsrc((void*)(F.out + (size_t)r0 * DM + k0), (short)0, 64 * DM * 4, 0x00020000);
    const __amdgpu_buffer_rsrc_t rsW = __builtin_amdgcn_make_buffer_rsrc((void*)((bf16*)(F.ws + WS_WR) + k0), (short)0, 160 * DM * 2, 0x00020000);
    const __amdgpu_buffer_rsrc_t rsU = __builtin_amdgcn_make_buffer_rsrc((void*)((bf16*)(F.ws + WS_U) + (size_t)r0 * DM + k0), (short)0, 64 * DM * 2, 0x00020000);
    const unsigned hL = (unsigned)(li * DM + 8 * g) * 4u, wL = (unsigned)(li * DM + 8 * g) * 2u;
    const char* gB = (const char*)(F.in[10] + k0); const unsigned gL = (unsigned)(8 * g) * 4u;
#define RT_X(rb, s, j) __builtin_bit_cast(f32x4, __builtin_amdgcn_raw_buffer_load_b128(rsH, hL, (unsigned)((16 * (rb)) * DM * 4 + 128 * (s) + 16 * (j)), 0))
#define RT_W(lo, cb, s) __builtin_bit_cast(bf16x8, __builtin_amdgcn_raw_buffer_load_b128(rsW, wL, (unsigned)((lo) * 80 * DM * 2 + (16 * (cb)) * DM * 2 + 64 * (s)), 0))
    f32x4 xa[4][2], xb[4][2];
#pragma unroll
    for (int rb = 0; rb < 4; ++rb) { xa[rb][0] = RT_X(rb, 0, 0); xa[rb][1] = RT_X(rb, 0, 1); }
    bf16x8 bh[5], bl[5];
#pragma unroll
    for (int cb = 0; cb < 5; ++cb) { bh[cb] = RT_W(0, cb, 0); bl[cb] = RT_W(1, cb, 0); }
    f32x4 ga = *(const f32x4*)(gB + gL), gb = *(const f32x4*)(gB + 16 + gL);
#define RT_STEP(s, XC, XN) do { \
        const int sn = (s) + 1 < 8 ? (s) + 1 : 7;                    \
        _Pragma("unroll") for (int rb = 0; rb < 4; ++rb) { XN[rb][0] = RT_X(rb, sn, 0); XN[rb][1] = RT_X(rb, sn, 1); } \
        __builtin_amdgcn_sched_barrier(0); \
        bf16x8 ah[4], al[4]; \
        _Pragma("unroll") for (int rb = 0; rb < 4; ++rb) { \
            const f32x4 v0 = XC[rb][0] * rstd[rb] * ga, v1 = XC[rb][1] * rstd[rb] * gb; \
            u32x4 hw; hw.x = cvtpk(v0[0], v0[1]); hw.y = cvtpk(v0[2], v0[3]); hw.z = cvtpk(v1[0], v1[1]); hw.w = cvtpk(v1[2], v1[3]); \
            u32x4 lw; lw.x = cvtpk(v0[0] - bf_lo(hw.x), v0[1] - bf_hi(hw.x)); lw.y = cvtpk(v0[2] - bf_lo(hw.y), v0[3] - bf_hi(hw.y)); \
            lw.z = cvtpk(v1[0] - bf_lo(hw.z), v1[1] - bf_hi(hw.z)); lw.w = cvtpk(v1[2] - bf_lo(hw.w), v1[3] - bf_hi(hw.w)); \
            __builtin_amdgcn_raw_buffer_store_b128(hw, rsU, wL, (unsigned)((16 * rb) * DM * 2 + 64 * (s)), 0); \
            ah[rb] = __builtin_bit_cast(bf16x8, hw); al[rb] = __builtin_bit_cast(bf16x8, lw); } \
        ga = *(const f32x4*)(gB + (size_t)(128 * sn) + gL); gb = *(const f32x4*)(gB + (size_t)(128 * sn + 16) + gL); \
        __builtin_amdgcn_sched_barrier(0); \
        _Pragma("unroll") for (int cb = 0; cb < 5; ++cb) { \
            _Pragma("unroll") for (int rb = 0; rb < 4; ++rb) acc[rb][cb] = MFMA16(ah[rb], bh[cb], acc[rb][cb]); \
            _Pragma("unroll") for (int rb = 0; rb < 4; ++rb) acc[rb][cb] = MFMA16(al[rb], bh[cb], acc[rb][cb]); \
            _Pragma("unroll") for (int rb = 0; rb < 4; ++rb) acc[rb][cb] = MFMA16(ah[rb], bl[cb], acc[rb][cb]); \
            __builtin_amdgcn_sched_barrier(0); \
            bh[cb] = RT_W(0, cb, sn); bl[cb] = RT_W(1, cb, sn); } \
        __builtin_amdgcn_sched_barrier(0); } while (0)
#pragma nounroll
    for (int s = 0; s < 8; s += 2) { RT_STEP(s, xa, xb); RT_STEP(s + 1, xb, xa); }
#undef RT_STEP
#undef RT_X
#undef RT_W
    LAS float* part = (LAS float*)F.lds;
    LAS float* red = part + 8 * 2560;
#pragma unroll
    for (int half = 0; half < 2; ++half) {
        if (half) __syncthreads();
#pragma unroll
        for (int rb = 0; rb < 2; ++rb)
#pragma unroll
            for (int cb = 0; cb < 5; ++cb)
#pragma unroll
                for (int r = 0; r < 4; ++r) part[w * 2560 + (16 * rb + 4 * g + r) * 80 + 16 * cb + li] = acc[2 * half + rb][cb][r];
        __syncthreads();
        for (int e = F.tid; e < 2560; e += NWAVES * 64) { float t = part[e];
#pragma unroll
            for (int ww = 1; ww < 8; ++ww) t += part[ww * 2560 + e];
            red[half * 2560 + e] = t; }
    }
    __syncthreads();
    if (w == 0) router_select(F, red + lane * 80, r0 + lane);
    __syncthreads();
}
__device__ __forceinline__ void moe_tables(Frame& F, int x) {
    LAS int* tb = (LAS int*)(F.lds + MOE_TAB_OFF); LAS int* cn = tb + 128; LAS int* pt = tb + 256;
    __syncthreads();
    if (F.tid < 64) {
        const int e = F.tid, c = (int)__hip_atomic_load(F.ctl + CW_CNT + 64 * e, RLX_AGENT), t = (c + 255) >> 8;
        cn[e] = c;
        int incl = t;
#pragma unroll
        for (int o = 1; o < 64; o <<= 1) { const int v = __shfl_up(incl, o); if (e >= o) incl += v; }
        tb[e] = incl - t; if (e == 63) tb[64] = incl;
        int rank = 0;
        for (int o = 0; o < 64; ++o) { const int to = __shfl(t, o); rank += (to > t || (to == t && o < e)) ? 1 : 0; }
        if ((rank & 7) == x) { pt[16 + (rank >> 3)] = e; pt[24 + (rank >> 3)] = t; }
    }
    __syncthreads();
    if (F.tid == 0) { int b = 0; for (int k = 0; k < 8; ++k) { pt[k] = b; b += pt[24 + k]; } pt[8] = b; }
    __syncthreads();
}
template <bool WITH_Y> __device__ __forceinline__ void final_row(Frame& F, int tok, const LAS int* tb, const f32x4 (&gfv)[8]) {
    const int lane = F.lane;
    int4 ts = make_int4(0, 0, 0, 0); f32x2 wt = {0.f, 0.f}; if (WITH_Y) { ts = ((const int4*)(F.ws + WS_TOKSLOT))[tok]; wt = ((const f32x2*)(F.ws + WS_WL))[tok]; }
    const bf16* Y = (const bf16*)(F.ws + WS_Y);
    const u32x2* ya = (const u32x2*)(Y + (size_t)(WITH_Y ? tb[ts.x] * 256 + ts.y : 0) * DM) + lane; const u32x2* yb = (const u32x2*)(Y + (size_t)(WITH_Y ? tb[ts.z] * 256 + ts.w : 0) * DM) + lane;
    f32x4* hr = (f32x4*)(F.out + (size_t)tok * DM) + lane; f32x4* ho = F.dup ? (f32x4*)((float*)(F.ws + WS_U) + (size_t)tok * DM) + lane : hr;
    f32x4 v[8]; float s = 0.f;
#pragma unroll
    for (int j = 0; j < 8; ++j) { f32x4 h = __builtin_nontemporal_load(hr + 64 * j);
        if (WITH_Y) { const u32x2 a = __builtin_nontemporal_load(ya + 64 * j), b = __builtin_nontemporal_load(yb + 64 * j); h[0] += wt.x * bf_lo(a.x) + wt.y * bf_lo(b.x); h[1] += wt.x * bf_hi(a.x) + wt.y * bf_hi(b.x); h[2] += wt.x * bf_lo(a.y) + wt.y * bf_lo(b.y); h[3] += wt.x * bf_hi(a.y) + wt.y * bf_hi(b.y); }
        v[j] = h; s += (h[0] * h[0] + h[1] * h[1]) + (h[2] * h[2] + h[3] * h[3]); }
    const float r = 1.0f / sqrtf(wave_sum(s) * (1.f / DM) + EPS);
#pragma unroll
    for (int j = 0; j < 8; ++j) __builtin_nontemporal_store(v[j] * r * gfv[j], ho + 64 * j);
}
#ifndef MK_N_LAUNCHES
#define MK_N_LAUNCHES 1
#endif
#ifndef MK_PHASE_MASK
#define MK_PHASE_MASK 0x3ff
#endif
#ifndef MK_DUP_MASK
#define MK_DUP_MASK 0
#endif
#ifndef MK_REP_DIFF
#define MK_REP_DIFF 1
#endif
#ifndef MK_REP_RET
#define MK_REP_RET 1
#endif
#ifndef MK_BRINGUP
#define MK_BRINGUP 3
#endif
constexpr int N_PHASES = 10;
struct Args { const float* in[17]; float* out; unsigned char* ws; int ph_lo, ph_hi, dup, pad; };
__global__ void __launch_bounds__(NWAVES * 64, 2) mk_fwd(Args args) {
    extern __shared__ __attribute__((aligned(16))) unsigned char lds[];
    Frame F;
    F.lds = (LAS unsigned char*)lds;
    F.MISC = (volatile LAS unsigned*)(F.lds + MISC_OFF);
    F.tid = threadIdx.x; F.lane = F.tid & 63; F.wave = __builtin_amdgcn_readfirstlane(F.tid >> 6);
    F.G = gridDim.x; const int bx = blockIdx.x; const int vcu = (F.G % 8 == 0) ? (bx % 8) * (F.G / 8) + bx / 8 : bx;
    F.gw = bx * NWAVES + F.wave; F.ngw = F.G * NWAVES;
    F.ws = args.ws; F.ctl = (gu32*)(args.ws + WS_CTL); F.out = args.out; F.dup = args.dup;
#pragma unroll
    for (int i = 0; i < 17; ++i) F.in[i] = args.in[i];
    for (int u = F.tid; u < (LDS_BYTES - LDSCTL_OFF) / 4; u += NWAVES * 64) ((LAS unsigned*)(F.lds + LDSCTL_OFF))[u] = 0u;
    __syncthreads();
    XcdBarrier bar = xcd_barrier_post((unsigned*)(F.ctl + CW_BAR), F.MISC + 8);
    const int lo = args.ph_lo, hi = args.ph_hi;
#define IN(k) (lo <= (k) && (k) < hi && ((MK_PHASE_MASK >> (k)) & 1))
#define SEAM(k) do { if ((k) + 1 < hi) xcd_barrier(bar); } while (0)

    if (lo <= 0 && 0 < hi) { if ((MK_PHASE_MASK >> 0) & 1) p0_prologue(F); SEAM(0); }
    if (lo <= 1 && 1 < hi) { if ((MK_PHASE_MASK >> 1) & 1) {
        if (bx < 112) meta_proj_task(F, bx);
        pg8::Gemm g{(const bf16*)(F.ws + WS_U), (const bf16*)(F.ws + WS_WIN), NTOK, NIN, DM};
        EpiProj E{(bf16*)(F.ws + WS_P), (const f32x2*)(F.ws + WS_TAB_RET), (const f32x2*)(F.ws + WS_TAB_DIFF)};
        { pg8::StaticOrder S; S.init(NTOK, NIN, F.G, bx); pg8::gemm_phase<EpiProj, pg8::StaticOrder, false>(F.lds, g, S, E); } }
        SEAM(1); }
    if (lo <= 2 && 2 < hi) { if ((MK_PHASE_MASK >> 2) & 1) { for (int u = vcu; u < 512; u += F.G) ret_kv_unit(F, u >> 7, (u >> 5) & 3, u & 31); }
        SEAM(2); }
    if (lo <= 3 && 3 < hi) { if ((MK_PHASE_MASK >> 3) & 1) ret_scan(F);
        if (MK_N_LAUNCHES == 1) {
            asm volatile("s_waitcnt vmcnt(0)" ::: "memory"); __syncthreads();
            if (F.tid == 0) { __builtin_amdgcn_fence(__ATOMIC_RELEASE, "agent"); asm volatile("s_waitcnt vmcnt(0)" ::: "memory"); (void)xb_add((unsigned*)(F.ctl + CW_SPLIT), 1u); }
        } else SEAM(3); }
    if (lo <= 4 && 4 < hi) { if ((MK_PHASE_MASK >> 4) & 1) {
#if MK_GU_IN_P4
#define GU_SHARE() do { __syncthreads(); { const int a0_ = TR_I_IN + TR_I_OUT, n0_ = MK_LATE_WD ? TR_ITEMS - TR_I_D : TR_ITEMS, per2_ = 2 * (((n0_ - a0_ + F.G - 1) / F.G + 7) & ~7), \
        st_ = a0_ + (vcu >> 1) * per2_, on_ = (per2_ * MK_GU_FIRST_PCT / 100 + 7) & ~7, lo_ = (vcu & 1) ? st_ : st_ + on_, hi_ = (vcu & 1) ? st_ + on_ : st_ + per2_; \
        p0_weights(F, lo_ < n0_ ? lo_ : n0_, hi_ < n0_ ? hi_ : n0_, F.wave, NWAVES); } LDS_WAIT(); __syncthreads(); } while (0)
        const int gslot = F.dup ? 3 : (vcu & 1);
#else
#define GU_SHARE() do { } while (0)
        const int gslot = 3;
#endif
        if (gslot == 1) GU_SHARE();
        for (int rep_ = 0; rep_ < MK_REP_DIFF; ++rep_)
        for (int p2 = 2 * vcu; p2 < 512; p2 += 2 * F.G) {
#pragma nounroll
            for (int k = 0; k < 2; ++k) { const int bh = p2 >> 5, s = (p2 >> 1) & 15; diff_unit(F, bh >> 2, bh & 3, k ? s : 31 - s); } }
        if (MK_N_LAUNCHES == 1) {
            if (F.tid == 0) { unsigned* bw_ = (unsigned*)(F.ctl + CW_BAR); XB_SPIN(xb_ld((unsigned*)(F.ctl + CW_SPLIT)) < (unsigned)F.G, bw_);
                __builtin_amdgcn_fence(__ATOMIC_ACQUIRE, "agent"); asm volatile("s_waitcnt vmcnt(0)" ::: "memory"); }
            __syncthreads(); }
        if (MK_BRINGUP >= 2) { for (int rep_ = 0; rep_ < MK_REP_RET; ++rep_) for (int u = vcu; u < 512; u += F.G) ret_out_unit(F, u >> 7, (u >> 5) & 3, (u & 31) + 1); }
        else { u32x4* m4 = (u32x4*)(F.ws + WS_MIXED); for (int e = F.gw * 64 + F.lane; e < NTOK * 128; e += F.ngw * 64) m4[(size_t)(e >> 7) * 256 + (e & 127)] = (u32x4){0u, 0u, 0u, 0u}; }
        if (gslot == 0) GU_SHARE();
#undef GU_SHARE
        }
        SEAM(4); }
    if (lo <= 5 && 5 < hi) { if ((MK_PHASE_MASK >> 5) & 1) {
        pg8::Gemm g{(const bf16*)(F.ws + WS_MIXED), (const bf16*)(F.ws + WS_WOUT), NTOK, DM, DM}; pg8::StaticOrder S; S.init(NTOK, DM, F.G, bx);
        EpiH1 E{F.in[0], F.out, (float*)(F.ws + WS_SSP)};
        pg8::gemm_phase<EpiH1, pg8::StaticOrder, false>(F.lds, g, S, E); }
        SEAM(5); }
    if (lo <= 6 && 6 < hi) { if ((MK_PHASE_MASK >> 6) & 1) { for (int t = bx; t < NTOK / 64; t += F.G) router_task(F, t); }
        SEAM(6); }
    if (lo <= 7 && 7 < hi) { if ((MK_PHASE_MASK >> 7) & 1) {
        moe_tables(F, bx & 7);
        const LAS int* tb = (const LAS int*)(F.lds + MOE_TAB_OFF); const LAS int* cn = tb + 128; LAS unsigned* rowtab = (LAS unsigned*)(F.lds + MOE_ROWTAB_OFF);
        MoeSched S{tb, cn, rowtab, tb + 256, (const int*)(F.ws + WS_LIST), 4, bx & 7, bx >> 3, F.G >> 3};
        { pg8::Unit u; const int* list = (const int*)(F.ws + WS_LIST);
          for (int i = 0; i < 7 && S.next(i, u); ++i) if (F.tid < 256) { const int e = u.pn >> 2, r = (u.pm - tb[e]) * 256 + F.tid;
              const int tok = list[(size_t)e * NTOK + (r < cn[e] ? r : 0)]; rowtab[i * 256 + F.tid] = (unsigned)tok * (unsigned)(DM * 2); }
          __syncthreads(); }
        pg8::Gemm g{(const bf16*)(F.ws + WS_U), (const bf16*)(F.ws + WS_WGU), MAXSLOT, NEXP * 1024, DM};
        EpiAct E{(bf16*)(F.ws + WS_HACT)};
        pg8::gemm_phase<EpiAct, MoeSched, true, false>(F.lds, g, S, E);
#if MK_LATE_WD
        if (!F.dup) for (;;) {
            __syncthreads();
            if (F.tid == 0) F.MISC[12] = __hip_atomic_fetch_add(F.ctl + CW_Q, 1u, RLX_AGENT);
            __syncthreads();
            const int grab = (int)F.MISC[12];
            if (grab * 64 >= TR_I_D) break;
            p0_weights(F, TR_ITEMS - TR_I_D + grab * 64, TR_ITEMS - TR_I_D + grab * 64 + 64, F.wave, NWAVES);
        }
#endif
        }
        SEAM(7); }
    if (lo <= 8 && 8 < hi) { if ((MK_PHASE_MASK >> 8) & 1) {
        if (MK_N_LAUNCHES != 1) moe_tables(F, bx & 7);
        const LAS int* tb = (const LAS int*)(F.lds + MOE_TAB_OFF); const LAS int* cn = tb + 128;
        MoeSched S{tb, cn, nullptr, tb + 256, nullptr, 8, bx & 7, bx >> 3, F.G >> 3};
        pg8::Gemm g{(const bf16*)(F.ws + WS_HACT), (const bf16*)(F.ws + WS_WD), MAXSLOT, NEXP * DM, FF};
        EpiY E{(bf16*)(F.ws + WS_Y), tb, cn};
        pg8::gemm_phase<EpiY, MoeSched, false, false>(F.lds, g, S, E); }
        SEAM(8); }
    if (lo <= 9 && 9 < hi) { if ((MK_PHASE_MASK >> 9) & 1) {
        if (MK_N_LAUNCHES != 1) moe_tables(F, bx & 7);
        const LAS int* tb = (const LAS int*)(F.lds + MOE_TAB_OFF);
        f32x4 gfv[8];
#pragma unroll
        for (int j = 0; j < 8; ++j) gfv[j] = ((const f32x4*)F.in[16])[F.lane + 64 * j];
        for (int t = F.gw; t < NTOK; t += F.ngw) final_row<(MK_BRINGUP >= 3)>(F, t, tb, gfv); } }
#undef IN
#undef SEAM
}

extern "C" void kernel_launch(void* const* d_in, const int* in_sizes, int n_in, void* d_out, int out_size, void* d_ws, size_t ws_size, hipStream_t stream) {
    static int grid = 0;
    if (grid == 0) {
        if (n_in != 17 || out_size != NTOK * DM || ws_size < WS_END) { fprintf(stderr, "kernel_launch: unexpected shapes (n_in %d out %d ws %zu, need ws >= %zu); nothing launched\n", n_in, out_size, ws_size, (size_t)WS_END); grid = -1; return; }
        int dev = 0, cus = 0, per_cu = 0;
        if (hipGetDevice(&dev) != hipSuccess || hipDeviceGetAttribute(&cus, hipDeviceAttributeMultiprocessorCount, dev) != hipSuccess) { grid = -1; return; }
        if (hipFuncSetAttribute((const void*)mk_fwd, hipFuncAttributeMaxDynamicSharedMemorySize, LDS_BYTES) != hipSuccess) { fprintf(stderr, "kernel_launch: hipFuncSetAttribute failed\n"); grid = -1; return; }
        if (hipOccupancyMaxActiveBlocksPerMultiprocessor(&per_cu, (const void*)mk_fwd, NWAVES * 64, LDS_BYTES) != hipSuccess || per_cu < 1) fprintf(stderr, "kernel_launch: occupancy query reports %d blocks per CU\n", per_cu);
        (void)hipGetLastError();
        grid = cus - (cus & 7);
    }
    if (grid < 0) return;
    if (hipMemsetAsync((char*)d_ws + WS_CTL, 0, CTL_ZERO_BYTES, stream) != hipSuccess) return;
    Args a{};
    for (int i = 0; i < 17; ++i) a.in[i] = (const float*)d_in[i];
    a.out = (float*)d_out; a.ws = (unsigned char*)d_ws;
    if (MK_N_LAUNCHES == 1) { a.ph_lo = 0; a.ph_hi = N_PHASES; hipLaunchKernelGGL(mk_fwd, dim3(grid), dim3(NWAVES * 64), LDS_BYTES, stream, a); }
    else for (int p = 0; p < N_PHASES; ++p) for (int rep = 0; rep < (((MK_DUP_MASK >> p) & 1) ? 2 : 1); ++rep) { a.ph_lo = p; a.ph_hi = p + 1; a.dup = (((MK_DUP_MASK >> p) & 1) && rep == 0 && (p == 5 || p == 6 || p == 9)) ? 1 : 0; hipLaunchKernelGGL(mk_fwd, dim3(grid), dim3(NWAVES * 64), LDS_BYTES, stream, a); }
}
```
